# Optimizing an MI355X kernel written in HIP

```python
import jax, jax.numpy as jnp
from jax import lax
import numpy as np

D_MODEL = 1024
BATCH = 8
SEQ = 4096
DEPTH = 4

CHUNK = 64
N_MIXERS = 2
EXPAND = 2
BRANCH = EXPAND * D_MODEL
GMLP_BLOCK = 128
A_GROUPS = 8
A_GROUP_DIM = BRANCH // A_GROUPS
POOL_WINDOWS = (2, 4, 8, 16)
B_GROUPS = len(POOL_WINDOWS)
B_GROUP_DIM = BRANCH // B_GROUPS
N_A = (DEPTH + 1) // 2
N_B = DEPTH // 2
EPS = 1e-6

kernel_name = "hybrid_gmlp_pool_sandwich_trunk"


def rms_norm(x, g):
    xf = x.astype(jnp.float32)
    y = xf * lax.rsqrt(jnp.mean(xf * xf, axis=-1, keepdims=True) + EPS)
    return (y * g.astype(jnp.float32)).astype(x.dtype)


def layer_norm(x, g, b):
    xf = x.astype(jnp.float32)
    mu = jnp.mean(xf, axis=-1, keepdims=True)
    xc = xf - mu
    y = xc * lax.rsqrt(jnp.mean(xc * xc, axis=-1, keepdims=True) + EPS)
    return (y * g.astype(jnp.float32) + b.astype(jnp.float32)).astype(x.dtype)


def spatial_mask():
    p = jnp.arange(GMLP_BLOCK)
    return (p[None, :] // CHUNK) <= (p[:, None] // CHUNK)


def gmlp_mixer(h, w_in, ln_g, ln_b, w_s, b_s, w_out):
    B, S, _ = h.shape
    proj = h @ w_in
    u, v, z = jnp.split(proj, 3, axis=-1)
    u = jax.nn.gelu(u)
    v = layer_norm(jax.nn.gelu(v), ln_g, ln_b)
    vb = v.reshape(B, S // GMLP_BLOCK, GMLP_BLOCK, A_GROUPS, A_GROUP_DIM)
    w = jnp.where(spatial_mask()[None], w_s, jnp.zeros_like(w_s))
    mixed = jnp.einsum('gpq,bnqgc->bnpgc', w, vb)
    mixed = mixed + jnp.transpose(b_s)[None, None, :, :, None]
    mixed = mixed.reshape(B, S, BRANCH)
    y = u * mixed * jax.nn.silu(z)
    return y @ w_out


def pool_mixer(h, w_in, w_grp, scale, w_out):
    B, S, _ = h.shape
    proj = h @ w_in
    xb, z = jnp.split(proj, 2, axis=-1)
    xf = xb.astype(jnp.float32)
    cs = jnp.concatenate([jnp.zeros((B, 1, BRANCH), jnp.float32),
                          jnp.cumsum(xf, axis=1)], axis=1)
    upper = cs[:, 1:]
    t1 = jnp.arange(1, S + 1, dtype=jnp.int32)
    outs = []
    for gi, win in enumerate(POOL_WINDOWS):
        sl = slice(gi * B_GROUP_DIM, (gi + 1) * B_GROUP_DIM)
        lower = jnp.pad(cs[:, :S + 1 - win, sl], ((0, 0), (win - 1, 0), (0, 0)))
        count = jnp.minimum(t1, win).astype(jnp.float32)[None, :, None]
        pooled = (upper[:, :, sl] - lower) / count - xf[:, :, sl]
        outs.append(jnp.einsum('bsc,cd->bsd', pooled.astype(xb.dtype), w_grp[gi]))
    mixed = jnp.concatenate(outs, axis=-1) * scale
    y = mixed * jax.nn.silu(z)
    return y @ w_out


def setup_inputs(seed: int = 0) -> dict:
    key = jax.random.key(seed)
    ks = jax.random.split(key, 16)
    f32 = jnp.float32
    nrm = lambda k, shape, s: jax.random.normal(k, shape, f32) * s
    return {
        "x": nrm(ks[0], (BATCH, SEQ, D_MODEL), 1.0),
        "norm_pre": 1.0 + nrm(ks[1], (DEPTH, D_MODEL), 0.05),
        "norm_post": 1.0 + nrm(ks[2], (DEPTH, D_MODEL), 0.05),
        "a_w_in": nrm(ks[3], (N_A, D_MODEL, 3 * BRANCH), D_MODEL ** -0.5),
        "a_ln_g": 1.0 + nrm(ks[4], (N_A, BRANCH), 0.05),
        "a_ln_b": nrm(ks[5], (N_A, BRANCH), 0.02),
        "a_w_s": nrm(ks[6], (N_A, A_GROUPS, GMLP_BLOCK, GMLP_BLOCK), GMLP_BLOCK ** -0.5),
        "a_b_s": 1.0 + nrm(ks[7], (N_A, A_GROUPS, GMLP_BLOCK), 0.05),
        "a_w_out": nrm(ks[8], (N_A, BRANCH, D_MODEL), BRANCH ** -0.5),
        "b_w_in": nrm(ks[9], (N_B, D_MODEL, 2 * BRANCH), D_MODEL ** -0.5),
        "b_w_grp": nrm(ks[10], (N_B, B_GROUPS, B_GROUP_DIM, B_GROUP_DIM), B_GROUP_DIM ** -0.5),
        "b_scale": 1.0 + nrm(ks[11], (N_B, BRANCH), 0.1),
        "b_w_out": nrm(ks[12], (N_B, BRANCH, D_MODEL), BRANCH ** -0.5),
    }


def reference(x, norm_pre, norm_post, a_w_in, a_ln_g, a_ln_b, a_w_s, a_b_s, a_w_out,
              b_w_in, b_w_grp, b_scale, b_w_out):
    for i in range(DEPTH):
        h = rms_norm(x, norm_pre[i])
        j = i // N_MIXERS
        if i % N_MIXERS == 0:
            out = gmlp_mixer(h, a_w_in[j], a_ln_g[j], a_ln_b[j], a_w_s[j], a_b_s[j], a_w_out[j])
        else:
            out = pool_mixer(h, b_w_in[j], b_w_grp[j], b_scale[j], b_w_out[j])
        x = x + rms_norm(out, norm_post[i])
    return x
```

```cpp
#include <hip/hip_runtime.h>
#include <hip/hip_cooperative_groups.h>
#include <cstdio>
#include <cstdint>
namespace cg = cooperative_groups;

#define LAS __attribute__((address_space(3)))
typedef unsigned short bf16_t;
typedef short bf16x8 __attribute__((ext_vector_type(8)));
typedef float f32x4 __attribute__((ext_vector_type(4)));
typedef float f32x2 __attribute__((ext_vector_type(2)));
typedef unsigned u32x4 __attribute__((ext_vector_type(4)));
typedef unsigned u32x2 __attribute__((ext_vector_type(2)));

constexpr int DM = 1024, BATCH = 8, SEQ = 4096, DEPTH = 4, EB = 2048, MTOK = BATCH * SEQ;
constexpr float EPS = 1e-6f;
constexpr int NWAVES = 8, NTHREADS = 512;

constexpr size_t MiB = 1u << 20;
constexpr size_t WS_WA_IN = 0;
constexpr size_t WS_WA_OUT = 24 * MiB;
constexpr size_t WS_WB_IN = 32 * MiB;
constexpr size_t WS_WB_GRP = 48 * MiB;
constexpr size_t WS_WB_OUT = 52 * MiB;
constexpr size_t WS_WS = 60 * MiB;
constexpr size_t WS_H = 61 * MiB;
constexpr size_t WS_BUF0 = 125 * MiB;
constexpr size_t WS_BUF1 = 253 * MiB;
constexpr size_t WS_BUF2 = 381 * MiB;
constexpr size_t WS_END = 509 * MiB;

namespace pg8 {
constexpr int BM = 256, BK = 64, HALF = 128, HTB = HALF * BK * 2, STAGE_BYTES = 8 * HTB, NXCD = 8, WGM = 8;
__host__ __device__ __forceinline__ int lds_byte(int r, int c) { const int st = (r >> 4) * 2 + (c >> 5), rr = r & 15, cc = c & 31, ob = rr * 64 + cc * 2; return st * 1024 + (ob ^ (((ob >> 9) & 1) << 5)); }
__host__ __device__ __forceinline__ void stage_rc(int b, int& R, int& C) { const int st = b / 1024, sb = b % 1024, swz = sb ^ (((sb >> 9) & 1) << 5); R = (st >> 1) * 16 + swz / 64; C = (st & 1) * 32 + (swz % 64) / 2; }
__host__ __device__ __forceinline__ int perm32(int rho) { const int n = rho >> 4, i = rho & 15; return 8 * (i >> 2) + 4 * n + (i & 3); }

struct Unit { int pm, pn; };
struct Gemm { const bf16_t* A; const bf16_t* Bt; int M, N, K, lda, a_gdiv, a_goff; };

struct StaticOrder {
    int nM, nN, nwg, G, c;
    __host__ __device__ void init(int M, int N, int G_, int c_) { nM = M / BM; nN = N / BM; nwg = nM * nN; G = G_; c = c_; }
    __host__ __device__ bool next(int i, Unit& u) const {
        const long L = (long)i * G + c; if (L >= nwg) return false;
        int wgid = (int)L; { const int q = nwg / NXCD, r = nwg % NXCD, xcd = wgid % NXCD, off = wgid / NXCD; wgid = (xcd < r ? xcd * (q + 1) : r * (q + 1) + (xcd - r) * q) + off; }
        const int nig = WGM * nN, gid = wgid / nig, fm = gid * WGM, gsz = (nM - fm) < WGM ? (nM - fm) : WGM;
        u.pm = fm + ((wgid % nig) % gsz); u.pn = (wgid % nig) / gsz; return true;
    }
};

__device__ __forceinline__ unsigned cvt_pk_bf16(float lo, float hi) { unsigned r; asm volatile("v_cvt_pk_bf16_f32 %0, %1, %2" : "=v"(r) : "v"(lo), "v"(hi)); return r; }
__device__ __forceinline__ float bf_lo(unsigned w) { return __uint_as_float(w << 16); }
__device__ __forceinline__ float bf_hi(unsigned w) { return __uint_as_float(w & 0xffff0000u); }
__device__ __forceinline__ float gelu_f(float x) { const float a = x * (1.0f + 0.044715f * x * x) * (-2.0f * 0.7978845608028654f * 1.4426950408889634f); return x * __builtin_amdgcn_rcpf(1.0f + __builtin_amdgcn_exp2f(a)); }
__device__ __forceinline__ float silu_f(float x) { return x * __builtin_amdgcn_rcpf(1.0f + __builtin_amdgcn_exp2f(x * -1.4426950408889634f)); }
__device__ __forceinline__ f32x4 gelu4(f32x4 v) { return (f32x4){gelu_f(v[0]), gelu_f(v[1]), gelu_f(v[2]), gelu_f(v[3])}; }
__device__ __forceinline__ f32x4 silu4(f32x4 v) { return (f32x4){silu_f(v[0]), silu_f(v[1]), silu_f(v[2]), silu_f(v[3])}; }
__device__ __forceinline__ u32x4 pack8(f32x4 a, f32x4 b) { u32x4 w; w.x = cvt_pk_bf16(a[0], a[1]); w.y = cvt_pk_bf16(a[2], a[3]); w.z = cvt_pk_bf16(b[0], b[1]); w.w = cvt_pk_bf16(b[2], b[3]); return w; }

struct EpiA1 {
    static constexpr bool PERM = true;
    bf16_t* V; bf16_t* UZ; f32x2* stats;
    __device__ __forceinline__ void operator()(const f32x4 (&acc)[2][2][4][2], const Unit& u, int wr, int wc, int fr, int fq) const {
        const int row0 = u.pm * BM + wr * 64 + fr;
        if (u.pn < 8) {
            const int col0 = u.pn * BM + wc * 32 + 8 * fq;
#pragma unroll
            for (int ai = 0; ai < 2; ++ai)
#pragma unroll
                for (int m = 0; m < 4; ++m) {
                    const int row = row0 + ai * HALF + m * 16; float s1 = 0.f, s2 = 0.f;
#pragma unroll
                    for (int bj = 0; bj < 2; ++bj) {
                        const f32x4 v0 = gelu4(acc[ai][bj][m][0]), v1 = gelu4(acc[ai][bj][m][1]);
                        s1 += ((v0[0] + v0[1]) + (v0[2] + v0[3])) + ((v1[0] + v1[1]) + (v1[2] + v1[3]));
                        s2 += ((v0[0] * v0[0] + v0[1] * v0[1]) + (v0[2] * v0[2] + v0[3] * v0[3])) + ((v1[0] * v1[0] + v1[1] * v1[1]) + (v1[2] * v1[2] + v1[3] * v1[3]));
                        *(u32x4*)(V + (size_t)row * EB + col0 + bj * HALF) = pack8(v0, v1);
                    }
                    s1 += __shfl_xor(s1, 16); s1 += __shfl_xor(s1, 32); s2 += __shfl_xor(s2, 16); s2 += __shfl_xor(s2, 32);
                    if (fq == 0) stats[((size_t)row * 8 + u.pn) * 4 + wc] = (f32x2){s1, s2};
                }
        } else {
            const int col0 = (u.pn - 8) * HALF + wc * 32 + 8 * fq;
#pragma unroll
            for (int ai = 0; ai < 2; ++ai)
#pragma unroll
                for (int m = 0; m < 4; ++m) {
                    const int row = row0 + ai * HALF + m * 16;
                    const f32x4 v0 = gelu4(acc[ai][0][m][0]) * silu4(acc[ai][1][m][0]), v1 = gelu4(acc[ai][0][m][1]) * silu4(acc[ai][1][m][1]);
                    *(u32x4*)(UZ + (size_t)row * EB + col0) = pack8(v0, v1);
                }
        }
    }
};
struct EpiB1 {
    static constexpr bool PERM = true;
    bf16_t* XB; bf16_t* SZ;
    __device__ __forceinline__ void operator()(const f32x4 (&acc)[2][2][4][2], const Unit& u, int wr, int wc, int fr, int fq) const {
        const int row0 = u.pm * BM + wr * 64 + fr; const bool isz = u.pn >= 8;
        bf16_t* O = isz ? SZ : XB; const int col0 = (u.pn & 7) * BM + wc * 32 + 8 * fq;
#pragma unroll
        for (int ai = 0; ai < 2; ++ai)
#pragma unroll
            for (int m = 0; m < 4; ++m) {
                const int row = row0 + ai * HALF + m * 16;
#pragma unroll
                for (int bj = 0; bj < 2; ++bj) {
                    f32x4 v0 = acc[ai][bj][m][0], v1 = acc[ai][bj][m][1];
                    if (isz) { v0 = silu4(v0); v1 = silu4(v1); }
                    *(u32x4*)(O + (size_t)row * EB + col0 + bj * HALF) = pack8(v0, v1);
                }
            }
    }
};
struct EpiB2 {
    static constexpr bool PERM = true;
    bf16_t* Y; const float* scale;
    __device__ __forceinline__ void operator()(const f32x4 (&acc)[2][2][4][2], const Unit& u, int wr, int wc, int fr, int fq) const {
        const int row0 = u.pm * BM + wr * 64 + fr; const int col0 = u.pn * BM + wc * 32 + 8 * fq;
        f32x4 sc[2][2];
#pragma unroll
        for (int bj = 0; bj < 2; ++bj) { sc[bj][0] = *(const f32x4*)(scale + col0 + bj * HALF); sc[bj][1] = *(const f32x4*)(scale + col0 + bj * HALF + 4); }
#pragma unroll
        for (int ai = 0; ai < 2; ++ai)
#pragma unroll
            for (int m = 0; m < 4; ++m) {
                const int row = row0 + ai * HALF + m * 16;
#pragma unroll
                for (int bj = 0; bj < 2; ++bj) {
                    u32x4* p = (u32x4*)(Y + (size_t)row * EB + col0 + bj * HALF); const u32x4 z = *p;
                    f32x4 v0 = acc[ai][bj][m][0] * sc[bj][0], v1 = acc[ai][bj][m][1] * sc[bj][1];
                    v0 = v0 * (f32x4){bf_lo(z.x), bf_hi(z.x), bf_lo(z.y), bf_hi(z.y)}; v1 = v1 * (f32x4){bf_lo(z.z), bf_hi(z.z), bf_lo(z.w), bf_hi(z.w)};
                    *p = pack8(v0, v1);
                }
            }
    }
};
struct EpiF32 {
    static constexpr bool PERM = false;
    float* C;
    __device__ __forceinline__ void operator()(const f32x4 (&acc)[2][2][4][2], const Unit& u, int wr, int wc, int fr, int fq) const {
        const int row0 = u.pm * BM + wr * 64 + fr, col0 = u.pn * BM + wc * 32 + 4 * fq;
#pragma unroll
        for (int ai = 0; ai < 2; ++ai)
#pragma unroll
            for (int m = 0; m < 4; ++m) { float* rowp = C + (size_t)(row0 + ai * HALF + m * 16) * DM + col0;
#pragma unroll
                for (int bj = 0; bj < 2; ++bj)
#pragma unroll
                    for (int n = 0; n < 2; ++n) *(f32x4*)(rowp + bj * HALF + n * 16) = acc[ai][bj][m][n]; }
    }
};

template <class Epi, bool ALIGN_EPI = true>
__device__ __forceinline__ void gemm_phase(LAS unsigned char* lds, const Gemm g, const StaticOrder& S, const Epi& E) {
    int tid = threadIdx.x; asm volatile("" : "+v"(tid));
    const int wid = __builtin_amdgcn_readfirstlane(tid >> 6), lane = tid & 63, wr = wid >> 2, wc = wid & 3, fr = lane & 15, fq = lane >> 4;
    const int K = g.K, nt = K / BK, lda = g.lda;
    unsigned voffA[2], voffB[2];
#pragma unroll
    for (int i = 0; i < 2; ++i) { int R, C; stage_rc(tid * 16 + i * 8192, R, C); const int Rb = Epi::PERM ? ((R & ~31) + perm32(R & 31)) : R;
        voffA[i] = (unsigned)(R * lda + C) * 2u; voffB[i] = (unsigned)(Rb * K + C) * 2u; }
    const size_t kstep = (size_t)(BK * 2);
    const size_t hstepA = (size_t)HALF * lda * 2, hstepB = (size_t)HALF * K * 2;
    const unsigned ldsw = (unsigned)wid * 1024u;
    const int aoff = lds_byte(wr * 64 + fr, fq * 8), boff = lds_byte(wc * 32 + fr, fq * 8);
#define PG8_APTR(u) ((const char*)g.A + ((size_t)(u).pm * BM * lda + (size_t)(g.a_gdiv ? ((u).pn / g.a_gdiv) * g.a_goff : 0)) * 2)
#define PG8_BPTR(u) ((const char*)g.Bt + (size_t)(u).pn * BM * K * 2)
#define PG8_SA(b, h) (((b) * 2 + (h)) * HTB)
#define PG8_SB(b, h) ((4 + (b) * 2 + (h)) * HTB)
#define PG8_STAGE(bufoff, gbase, voff) do { _Pragma("unroll") for (int _i = 0; _i < 2; ++_i) \
        __builtin_amdgcn_global_load_lds((const unsigned*)((const char*)(gbase) + (voff)[_i]), (LAS unsigned*)(lds + (bufoff) + ldsw + _i * 8192), 16, 0, 0); } while (0)
#define PG8_LDA(dst, b, h) do { _Pragma("unroll") for (int m = 0; m < 4; ++m) _Pragma("unroll") for (int k = 0; k < 2; ++k) dst[m][k] = *(const LAS bf16x8*)(lds + PG8_SA(b, h) + aoff + m * 2048 + k * 1024); } while (0)
#define PG8_LDB(dst, b, h) do { _Pragma("unroll") for (int n = 0; n < 2; ++n) _Pragma("unroll") for (int k = 0; k < 2; ++k) dst[n][k] = *(const LAS bf16x8*)(lds + PG8_SB(b, h) + boff + n * 2048 + k * 1024); } while (0)
#define PG8_MMA(ai, bj, At, Bt) do { __builtin_amdgcn_s_setprio(1); _Pragma("unroll") for (int m = 0; m < 4; ++m) _Pragma("unroll") for (int n = 0; n < 2; ++n) _Pragma("unroll") for (int k = 0; k < 2; ++k) \
        acc[ai][bj][m][n] = __builtin_amdgcn_mfma_f32_16x16x32_bf16(Bt[n][k], At[m][k], acc[ai][bj][m][n], 0, 0, 0); __builtin_amdgcn_s_setprio(0); } while (0)
#define PG8_WAIT_V(n) asm volatile("s_waitcnt vmcnt(" #n ")" ::: "memory")
#define PG8_WAIT_L(n) asm volatile("s_waitcnt lgkmcnt(" #n ")" ::: "memory")
#define PG8_BAR __builtin_amdgcn_s_barrier()
#define PG8_SCHED __builtin_amdgcn_sched_barrier(0)
    Unit cur, nxt; int ui = 0;
    if (!S.next(0, cur)) return;
    f32x4 acc[2][2][4][2];
#pragma unroll
    for (int a = 0; a < 2; ++a)
#pragma unroll
        for (int b = 0; b < 2; ++b)
#pragma unroll
            for (int m = 0; m < 4; ++m)
#pragma unroll
                for (int n = 0; n < 2; ++n) acc[a][b][m][n] = (f32x4){0.f, 0.f, 0.f, 0.f};
    bf16x8 At[4][2], B0[2][2], B1[2][2];
    const char* cA = PG8_APTR(cur); const char* cB = PG8_BPTR(cur);
    PG8_STAGE(PG8_SB(0, 0), cB, voffB); PG8_STAGE(PG8_SB(0, 1), cB + hstepB, voffB); PG8_STAGE(PG8_SA(0, 0), cA, voffA); PG8_STAGE(PG8_SA(0, 1), cA + hstepA, voffA);
    if (wr == 1) PG8_BAR;
    PG8_WAIT_V(2); PG8_BAR;
    PG8_STAGE(PG8_SB(1, 0), cB + kstep, voffB); PG8_STAGE(PG8_SA(1, 0), cA + kstep, voffA); PG8_STAGE(PG8_SB(1, 1), cB + hstepB + kstep, voffB);
    PG8_WAIT_V(6); PG8_BAR;
    for (;;) {
        const bool has_next = S.next(ui + 1, nxt);
        const char* nA = has_next ? PG8_APTR(nxt) : cA; const char* nB = has_next ? PG8_BPTR(nxt) : cB;
        for (int t = 0; t < nt; t += 2) {
            const bool last = (t == nt - 2);
            const char* a1 = cA + (size_t)(t + 1) * kstep;
            const char* a2 = last ? nA : cA + (size_t)(t + 2) * kstep; const char* b2 = last ? nB : cB + (size_t)(t + 2) * kstep;
            const char* a3 = a2 + kstep; const char* b3 = b2 + kstep;
            PG8_LDB(B0, 0, 0); PG8_LDB(B1, 0, 1); PG8_SCHED; PG8_LDA(At, 0, 0); PG8_STAGE(PG8_SA(1, 1), a1 + hstepA, voffA);
            PG8_WAIT_V(8); PG8_WAIT_L(0); PG8_BAR; PG8_MMA(0, 0, At, B0); PG8_MMA(0, 1, At, B1); PG8_BAR; PG8_SCHED;
            PG8_LDA(At, 0, 1); PG8_STAGE(PG8_SB(0, 0), b2, voffB); PG8_STAGE(PG8_SB(0, 1), b2 + hstepB, voffB); PG8_STAGE(PG8_SA(0, 0), a2, voffA);
            PG8_WAIT_V(8); PG8_WAIT_L(0); PG8_BAR; PG8_MMA(1, 0, At, B0); PG8_MMA(1, 1, At, B1); PG8_BAR; PG8_SCHED;
            PG8_LDB(B0, 1, 0); PG8_LDB(B1, 1, 1); PG8_SCHED; PG8_LDA(At, 1, 0); PG8_STAGE(PG8_SA(0, 1), a2 + hstepA, voffA);
            PG8_WAIT_V(8); PG8_WAIT_L(0); PG8_BAR; PG8_MMA(0, 0, At, B0); PG8_MMA(0, 1, At, B1); PG8_BAR; PG8_SCHED;
            PG8_LDA(At, 1, 1); PG8_STAGE(PG8_SB(1, 0), b3, voffB); PG8_STAGE(PG8_SB(1, 1), b3 + hstepB, voffB); PG8_STAGE(PG8_SA(1, 0), a3, voffA);
            PG8_WAIT_V(8); PG8_WAIT_L(0); PG8_BAR; PG8_MMA(1, 0, At, B0); PG8_MMA(1, 1, At, B1); PG8_BAR; PG8_SCHED;
        }
        if constexpr (ALIGN_EPI) { if (wr == 0) PG8_BAR; }
        E(acc, cur, wr, wc, fr, fq);
        if (!has_next) break;
#pragma unroll
        for (int a = 0; a < 2; ++a)
#pragma unroll
            for (int b = 0; b < 2; ++b)
#pragma unroll
                for (int m = 0; m < 4; ++m)
#pragma unroll
                    for (int n = 0; n < 2; ++n) acc[a][b][m][n] = (f32x4){0.f, 0.f, 0.f, 0.f};
        cur = nxt; cA = nA; cB = nB; ++ui;
        if constexpr (ALIGN_EPI) { if (wr == 1) PG8_BAR; }
    }
    PG8_WAIT_V(0);
    if constexpr (!ALIGN_EPI) { if (wr == 0) PG8_BAR; }
    PG8_BAR;
#undef PG8_APTR
#undef PG8_BPTR
#undef PG8_SA
#undef PG8_SB
#undef PG8_STAGE
#undef PG8_LDA
#undef PG8_LDB
#undef PG8_MMA
#undef PG8_WAIT_V
#undef PG8_WAIT_L
#undef PG8_BAR
#undef PG8_SCHED
}
}

__device__ __forceinline__ unsigned f2bf(float f) { unsigned u = __float_as_uint(f); return (u + 0x7fffu + ((u >> 16) & 1u)) >> 16; }
__device__ __forceinline__ float wave_sum(float v) {
#pragma unroll
    for (int o = 1; o < 64; o <<= 1) v += __shfl_xor(v, o);
    return v;
}

struct Params {
    const float* x; const float* norm_pre; const float* norm_post;
    const float* a_w_in; const float* a_ln_g; const float* a_ln_b; const float* a_w_s; const float* a_b_s; const float* a_w_out;
    const float* b_w_in; const float* b_w_grp; const float* b_scale; const float* b_w_out;
    float* out; unsigned char* ws;
};

typedef const __attribute__((address_space(4))) Params CParams;
__device__ __forceinline__ CParams* kparams() { CParams* kp = (CParams*)__builtin_amdgcn_kernarg_segment_ptr(); asm volatile("" : "+s"(kp)); return kp; }

__device__ __forceinline__ void transpose_item(const float* W, int ldw, int K, bf16_t* WT, int k0, int nsrc, int ndst, LAS float* scr, int lane) {
#pragma unroll 8
    for (int i = 0; i < 32; ++i) { const int kk = 2 * i + (lane >> 5); scr[kk * 33 + (lane & 31)] = W[(size_t)(k0 + kk) * ldw + nsrc + (lane & 31)]; }
    asm volatile("s_waitcnt lgkmcnt(0)" ::: "memory");
    const int c = lane & 7;
#pragma unroll
    for (int j = 0; j < 4; ++j) { const int n = (lane >> 3) + 8 * j; const LAS float* s = scr + (8 * c) * 33 + n;
        u32x4 o; o.x = pg8::cvt_pk_bf16(s[0 * 33], s[1 * 33]); o.y = pg8::cvt_pk_bf16(s[2 * 33], s[3 * 33]); o.z = pg8::cvt_pk_bf16(s[4 * 33], s[5 * 33]); o.w = pg8::cvt_pk_bf16(s[6 * 33], s[7 * 33]);
        *(u32x4*)(WT + (size_t)(ndst + n) * K + k0 + 8 * c) = o; }
    asm volatile("s_waitcnt lgkmcnt(0)" ::: "memory");
}

__device__ __forceinline__ int a_in_src_col(int n) { const int pn = n >> 8, r = n & 255; if (pn < 8) return 2048 + n; const int t = pn - 8; return r < 128 ? 128 * t + r : 4096 + 128 * t + (r - 128); }

__device__ __forceinline__ void p0_prologue(LAS unsigned char* lds, int bx, int G) {
    CParams* kp = kparams();
    struct { const float *x, *norm_pre, *a_w_in, *a_w_s, *a_w_out, *b_w_in, *b_w_grp, *b_w_out; unsigned char* ws; } P = {kp->x, kp->norm_pre, kp->a_w_in, kp->a_w_s, kp->a_w_out, kp->b_w_in, kp->b_w_grp, kp->b_w_out, kp->ws};
    int tid = threadIdx.x; asm volatile("" : "+v"(tid));
    const int lane = tid & 63, wave = __builtin_amdgcn_readfirstlane(tid >> 6), gw = bx * NWAVES + wave, NGW = G * NWAVES;
    LAS float* scr = (LAS float*)(lds + wave * 16384);
    unsigned char* ws = P.ws;
    constexpr int I_AIN = 16 * 192, I_AOUT = 32 * 32, I_BIN = 16 * 128, I_BGRP = 8 * 16, I_BOUT = 32 * 32;
    constexpr int NITEMS = 2 * I_AIN + 2 * I_AOUT + 2 * I_BIN + 8 * I_BGRP + 2 * I_BOUT;
    for (int it = gw; it < NITEMS; it += NGW) {
        int r = it;
        if (r < 2 * I_AIN) { const int j = r / I_AIN; r -= j * I_AIN; const int kb = r / 192, nb = r % 192;
            transpose_item(P.a_w_in + (size_t)j * 1024 * 6144, 6144, 1024, (bf16_t*)(ws + WS_WA_IN) + (size_t)j * 6144 * 1024, 64 * kb, a_in_src_col(32 * nb), 32 * nb, scr, lane); continue; }
        r -= 2 * I_AIN;
        if (r < 2 * I_AOUT) { const int j = r / I_AOUT; r -= j * I_AOUT; const int kb = r / 32, nb = r % 32;
            transpose_item(P.a_w_out + (size_t)j * 2048 * 1024, 1024, 2048, (bf16_t*)(ws + WS_WA_OUT) + (size_t)j * 1024 * 2048, 64 * kb, 32 * nb, 32 * nb, scr, lane); continue; }
        r -= 2 * I_AOUT;
        if (r < 2 * I_BIN) { const int j = r / I_BIN; r -= j * I_BIN; const int kb = r / 128, nb = r % 128;
            transpose_item(P.b_w_in + (size_t)j * 1024 * 4096, 4096, 1024, (bf16_t*)(ws + WS_WB_IN) + (size_t)j * 4096 * 1024, 64 * kb, 32 * nb, 32 * nb, scr, lane); continue; }
        r -= 2 * I_BIN;
        if (r < 8 * I_BGRP) { const int jg = r / I_BGRP; r -= jg * I_BGRP; const int kb = r / 16, nb = r % 16;
            transpose_item(P.b_w_grp + (size_t)jg * 512 * 512, 512, 512, (bf16_t*)(ws + WS_WB_GRP) + (size_t)jg * 512 * 512, 64 * kb, 32 * nb, 32 * nb, scr, lane); continue; }
        r -= 8 * I_BGRP;
        { const int j = r / I_BOUT; r -= j * I_BOUT; const int kb = r / 32, nb = r % 32;
            transpose_item(P.b_w_out + (size_t)j * 2048 * 1024, 1024, 2048, (bf16_t*)(ws + WS_WB_OUT) + (size_t)j * 1024 * 2048, 64 * kb, 32 * nb, 32 * nb, scr, lane); }
    }
    { bf16_t* wsb = (bf16_t*)(ws + WS_WS); const int gt = gw * 64 + lane, NT = NGW * 64;
      for (int i = gt; i < 2 * 8 * 128 * 128 / 4; i += NT) { const f32x4 v = *(const f32x4*)(P.a_w_s + (size_t)i * 4); const int q = (i * 4) & 127, p = ((i * 4) >> 7) & 127;
          const bool z = (p < 64) && (q >= 64); u32x2 o; o.x = z ? 0u : pg8::cvt_pk_bf16(v[0], v[1]); o.y = z ? 0u : pg8::cvt_pk_bf16(v[2], v[3]); *(u32x2*)(wsb + (size_t)i * 4) = o; } }
    { bf16_t* H = (bf16_t*)(ws + WS_H);
      f32x4 gp[4];
#pragma unroll
      for (int j = 0; j < 4; ++j) gp[j] = *((const f32x4*)P.norm_pre + lane + 64 * j);
      for (int m = gw; m < MTOK; m += NGW) {
          const f32x4* xr = (const f32x4*)(P.x + (size_t)m * DM) + lane; f32x4 v[4]; float s = 0.f;
#pragma unroll
          for (int j = 0; j < 4; ++j) { v[j] = xr[64 * j]; s += (v[j][0] * v[j][0] + v[j][1] * v[j][1]) + (v[j][2] * v[j][2] + v[j][3] * v[j][3]); }
          const float rstd = 1.0f / sqrtf(wave_sum(s) * (1.0f / DM) + EPS);
          u32x2* o = (u32x2*)(H + (size_t)m * DM) + lane;
#pragma unroll
          for (int j = 0; j < 4; ++j) { const f32x4 y = v[j] * rstd * gp[j]; u32x2 w; w.x = pg8::cvt_pk_bf16(y[0], y[1]); w.y = pg8::cvt_pk_bf16(y[2], y[3]); o[64 * j] = w; }
      } }
}

__device__ __forceinline__ void p4_norm_res(const float* O, const float* xin, float* xout, bf16_t* H, const float* g_post, const float* g_pre_next, int bx, int G) {
    int tid = threadIdx.x; asm volatile("" : "+v"(tid));
    const int lane = tid & 63, wave = __builtin_amdgcn_readfirstlane(tid >> 6), gw = bx * NWAVES + wave, NGW = G * NWAVES;
    f32x4 gq[4], gp[4];
#pragma unroll
    for (int j = 0; j < 4; ++j) { gq[j] = *((const f32x4*)g_post + lane + 64 * j); gp[j] = g_pre_next ? *((const f32x4*)g_pre_next + lane + 64 * j) : (f32x4){0.f, 0.f, 0.f, 0.f}; }
    for (int m = gw; m < MTOK; m += NGW) {
        const f32x4* orow = (const f32x4*)(O + (size_t)m * DM) + lane; const f32x4* xr = (const f32x4*)(xin + (size_t)m * DM) + lane;
        f32x4 o[4], xv[4]; float s = 0.f;
#pragma unroll
        for (int j = 0; j < 4; ++j) { o[j] = orow[64 * j]; xv[j] = xr[64 * j]; s += (o[j][0] * o[j][0] + o[j][1] * o[j][1]) + (o[j][2] * o[j][2] + o[j][3] * o[j][3]); }
        const float r1 = 1.0f / sqrtf(wave_sum(s) * (1.0f / DM) + EPS); float s2 = 0.f;
        f32x4* xo = (f32x4*)(xout + (size_t)m * DM) + lane;
#pragma unroll
        for (int j = 0; j < 4; ++j) { xv[j] = xv[j] + o[j] * r1 * gq[j]; xo[64 * j] = xv[j]; s2 += (xv[j][0] * xv[j][0] + xv[j][1] * xv[j][1]) + (xv[j][2] * xv[j][2] + xv[j][3] * xv[j][3]); }
        if (g_pre_next) {
            const float r2 = 1.0f / sqrtf(wave_sum(s2) * (1.0f / DM) + EPS);
            u32x2* ho = (u32x2*)(H + (size_t)m * DM) + lane;
#pragma unroll
            for (int j = 0; j < 4; ++j) { const f32x4 y = xv[j] * r2 * gp[j]; u32x2 w; w.x = pg8::cvt_pk_bf16(y[0], y[1]); w.y = pg8::cvt_pk_bf16(y[2], y[3]); ho[64 * j] = w; }
        }
    }
}

__device__ __forceinline__ void mix_phase(LAS unsigned char* lds, const bf16_t* V, bf16_t* UZ, const f32x2* stats, const bf16_t* WSb, const float* lng, const float* lnb, const float* bs, int G, int c) {
    constexpr int RS = 272;
    LAS unsigned char* VT = lds; LAS unsigned char* WL = lds + 256 * RS; LAS float* MU = (LAS float*)(lds + 384 * RS); LAS float* RD = MU + 128;
    int tid = threadIdx.x; asm volatile("" : "+v"(tid));
    const int wid = tid >> 6, lane = tid & 63, fr = lane & 15, fq = lane >> 4;
    for (int tile = c; tile < (MTOK / 128) * 8; tile += G) {
        const int nb = tile >> 3, g = tile & 7;
        if (tid < 128) {
            const f32x4* sp = (const f32x4*)(stats + (size_t)(nb * 128 + tid) * 32); float s1 = 0.f, s2 = 0.f;
#pragma unroll
            for (int i = 0; i < 16; ++i) { const f32x4 v = sp[i]; s1 += v[0] + v[2]; s2 += v[1] + v[3]; }
            const float mean = s1 * (1.0f / EB); const float var = s2 * (1.0f / EB) - mean * mean;
            MU[tid] = mean; RD[tid] = 1.0f / sqrtf(fmaxf(var, 0.f) + EPS);
        }
        for (int i = tid; i < 2048; i += NTHREADS) { const int p = i >> 4, ch = i & 15; *(LAS u32x4*)(WL + p * RS + ch * 16) = *(const u32x4*)(WSb + ((size_t)g * 128 + p) * 128 + ch * 8); }
        __syncthreads();
        {
            const int q = 16 * wid + (lane >> 2); const float mu = MU[q], rd = RD[q];
            const bf16_t* vrow = V + (size_t)(nb * 128 + q) * EB + g * 256;
#pragma unroll 2
            for (int i = 0; i < 8; ++i) {
                const int cc = (lane & 3) + 4 * i; const u32x4 raw = *(const u32x4*)(vrow + cc * 8);
                const f32x4 ga = *(const f32x4*)(lng + g * 256 + cc * 8), gb = *(const f32x4*)(lng + g * 256 + cc * 8 + 4), ba = *(const f32x4*)(lnb + g * 256 + cc * 8), bb = *(const f32x4*)(lnb + g * 256 + cc * 8 + 4);
                float val[8] = {pg8::bf_lo(raw.x), pg8::bf_hi(raw.x), pg8::bf_lo(raw.y), pg8::bf_hi(raw.y), pg8::bf_lo(raw.z), pg8::bf_hi(raw.z), pg8::bf_lo(raw.w), pg8::bf_hi(raw.w)};
#pragma unroll
                for (int e = 0; e < 8; ++e) { const float gg = e < 4 ? ga[e & 3] : gb[e & 3], bbv = e < 4 ? ba[e & 3] : bb[e & 3];
                    const float y = (val[e] - mu) * rd * gg + bbv; const int ch = cc * 8 + e; const int rho = (ch & ~31) + 16 * ((ch >> 2) & 1) + 4 * ((ch >> 3) & 3) + (ch & 3);
                    *(LAS unsigned short*)(VT + rho * RS + q * 2) = (unsigned short)f2bf(y); }
            }
        }
        __syncthreads();
        f32x4 acc[8][2];
#pragma unroll
        for (int m = 0; m < 8; ++m) { acc[m][0] = (f32x4){0.f, 0.f, 0.f, 0.f}; acc[m][1] = (f32x4){0.f, 0.f, 0.f, 0.f}; }
#pragma unroll
        for (int kk = 0; kk < 4; ++kk) {
            bf16x8 bfr[2];
#pragma unroll
            for (int n = 0; n < 2; ++n) bfr[n] = *(const LAS bf16x8*)(VT + (32 * wid + 16 * n + fr) * RS + (32 * kk + 8 * fq) * 2);
#pragma unroll
            for (int m = 0; m < 8; ++m) {
                if (m < 4 && kk >= 2) continue;
                const bf16x8 afr = *(const LAS bf16x8*)(WL + (16 * m + fr) * RS + (32 * kk + 8 * fq) * 2);
#pragma unroll
                for (int n = 0; n < 2; ++n) acc[m][n] = __builtin_amdgcn_mfma_f32_16x16x32_bf16(bfr[n], afr, acc[m][n], 0, 0, 0);
            }
        }
#pragma unroll
        for (int m = 0; m < 8; ++m) {
            const int p = 16 * m + fr; const float bias = bs[g * 128 + p];
            u32x4* ptr = (u32x4*)(UZ + (size_t)(nb * 128 + p) * EB + g * 256 + 32 * wid + 8 * fq); const u32x4 z = *ptr;
            const f32x4 v0 = (acc[m][0] + bias) * (f32x4){pg8::bf_lo(z.x), pg8::bf_hi(z.x), pg8::bf_lo(z.y), pg8::bf_hi(z.y)};
            const f32x4 v1 = (acc[m][1] + bias) * (f32x4){pg8::bf_lo(z.z), pg8::bf_hi(z.z), pg8::bf_lo(z.w), pg8::bf_hi(z.w)};
            *ptr = pg8::pack8(v0, v1);
        }
        __syncthreads();
    }
}

__device__ __forceinline__ void pool_phase(const bf16_t* XB, bf16_t* XP, int bx, int G) {
    constexpr int RUN = 32;
    int tid = threadIdx.x; asm volatile("" : "+v"(tid));
    const int gtid = bx * NTHREADS + tid, nthreads = G * NTHREADS;
    for (int item = gtid; item < (MTOK / RUN) * 256; item += nthreads) {
        const int r = item >> 8, cc = item & 255, gi = cc >> 6, w = 2 << gi;
        const int t0 = r * RUN, tt0 = t0 & (SEQ - 1);
        const bf16_t* xp = XB + (size_t)t0 * EB + cc * 8; bf16_t* op = XP + (size_t)t0 * EB + cc * 8;
        float sum[8];
#pragma unroll
        for (int e = 0; e < 8; ++e) sum[e] = 0.f;
        if (tt0 != 0) for (int s = 1; s < w; ++s) { const u32x4 v = *(const u32x4*)(xp - (size_t)s * EB);
            sum[0] += pg8::bf_lo(v.x); sum[1] += pg8::bf_hi(v.x); sum[2] += pg8::bf_lo(v.y); sum[3] += pg8::bf_hi(v.y); sum[4] += pg8::bf_lo(v.z); sum[5] += pg8::bf_hi(v.z); sum[6] += pg8::bf_lo(v.w); sum[7] += pg8::bf_hi(v.w); }
        for (int i = 0; i < RUN; ++i) {
            const int tt = tt0 + i; const u32x4 v = *(const u32x4*)(xp + (size_t)i * EB);
            const float xv[8] = {pg8::bf_lo(v.x), pg8::bf_hi(v.x), pg8::bf_lo(v.y), pg8::bf_hi(v.y), pg8::bf_lo(v.z), pg8::bf_hi(v.z), pg8::bf_lo(v.w), pg8::bf_hi(v.w)};
            const float inv = 1.0f / (float)(tt + 1 < w ? tt + 1 : w); float o[8];
#pragma unroll
            for (int e = 0; e < 8; ++e) { sum[e] += xv[e]; o[e] = sum[e] * inv - xv[e]; }
            u32x4 ov; ov.x = pg8::cvt_pk_bf16(o[0], o[1]); ov.y = pg8::cvt_pk_bf16(o[2], o[3]); ov.z = pg8::cvt_pk_bf16(o[4], o[5]); ov.w = pg8::cvt_pk_bf16(o[6], o[7]);
            *(u32x4*)(op + (size_t)i * EB) = ov;
            if (tt + 1 >= w) { const u32x4 d = *(const u32x4*)(xp + (size_t)(i - w + 1) * EB);
                sum[0] -= pg8::bf_lo(d.x); sum[1] -= pg8::bf_hi(d.x); sum[2] -= pg8::bf_lo(d.y); sum[3] -= pg8::bf_hi(d.y); sum[4] -= pg8::bf_lo(d.z); sum[5] -= pg8::bf_hi(d.z); sum[6] -= pg8::bf_lo(d.w); sum[7] -= pg8::bf_hi(d.w); }
        }
    }
}

constexpr int LDS_BYTES = 147456;


template <int L> __device__ __forceinline__ void run_layer(LAS unsigned char* lds, cg::grid_group& grid, const int bx, const int G) {
        const int j = L >> 1;
        if constexpr ((L & 1) == 0) {
            {
                CParams* kp = kparams(); unsigned char* ws = kp->ws;
                pg8::Gemm g{(const bf16_t*)(ws + WS_H), (const bf16_t*)(ws + WS_WA_IN) + (size_t)j * 6144 * 1024, MTOK, 6144, 1024, 1024, 0, 0};
                pg8::StaticOrder S; S.init(MTOK, 6144, G, bx);
                pg8::EpiA1 E{(bf16_t*)(ws + WS_BUF1), (bf16_t*)(ws + WS_BUF0), (f32x2*)(ws + WS_BUF2)};
                pg8::gemm_phase<pg8::EpiA1>(lds, g, S, E);
            }
            grid.sync();
            {
                CParams* kp = kparams(); unsigned char* ws = kp->ws;
                mix_phase(lds, (const bf16_t*)(ws + WS_BUF1), (bf16_t*)(ws + WS_BUF0), (const f32x2*)(ws + WS_BUF2), (const bf16_t*)(ws + WS_WS) + (size_t)j * 8 * 128 * 128, kp->a_ln_g + j * EB, kp->a_ln_b + j * EB, kp->a_b_s + j * 8 * 128, G, bx);
            }
            grid.sync();
            {
                CParams* kp = kparams(); unsigned char* ws = kp->ws;
                pg8::Gemm g{(const bf16_t*)(ws + WS_BUF0), (const bf16_t*)(ws + WS_WA_OUT) + (size_t)j * 1024 * 2048, MTOK, 1024, 2048, 2048, 0, 0};
                pg8::StaticOrder S; S.init(MTOK, 1024, G, bx);
                pg8::EpiF32 E{(float*)(ws + WS_BUF1)};
                pg8::gemm_phase<pg8::EpiF32>(lds, g, S, E);
            }
            grid.sync();
        } else {
            {
                CParams* kp = kparams(); unsigned char* ws = kp->ws;
                pg8::Gemm g{(const bf16_t*)(ws + WS_H), (const bf16_t*)(ws + WS_WB_IN) + (size_t)j * 4096 * 1024, MTOK, 4096, 1024, 1024, 0, 0};
                pg8::StaticOrder S; S.init(MTOK, 4096, G, bx);
                pg8::EpiB1 E{(bf16_t*)(ws + WS_BUF1), (bf16_t*)(ws + WS_BUF0)};
                pg8::gemm_phase<pg8::EpiB1>(lds, g, S, E);
            }
            grid.sync();
            { CParams* kp = kparams(); unsigned char* ws = kp->ws; pool_phase((const bf16_t*)(ws + WS_BUF1), (bf16_t*)(ws + WS_BUF2), bx, G); }
            grid.sync();
            {
                CParams* kp = kparams(); unsigned char* ws = kp->ws;
                pg8::Gemm g{(const bf16_t*)(ws + WS_BUF2), (const bf16_t*)(ws + WS_WB_GRP) + (size_t)j * 2048 * 512, MTOK, 2048, 512, 2048, 2, 512};
                pg8::StaticOrder S; S.init(MTOK, 2048, G, bx);
                pg8::EpiB2 E{(bf16_t*)(ws + WS_BUF0), kp->b_scale + j * EB};
                pg8::gemm_phase<pg8::EpiB2>(lds, g, S, E);
            }
            grid.sync();
            {
                CParams* kp = kparams(); unsigned char* ws = kp->ws;
                pg8::Gemm g{(const bf16_t*)(ws + WS_BUF0), (const bf16_t*)(ws + WS_WB_OUT) + (size_t)j * 1024 * 2048, MTOK, 1024, 2048, 2048, 0, 0};
                pg8::StaticOrder S; S.init(MTOK, 1024, G, bx);
                pg8::EpiF32 E{(float*)(ws + WS_BUF1)};
                pg8::gemm_phase<pg8::EpiF32>(lds, g, S, E);
            }
            grid.sync();
        }
        {
            CParams* kp = kparams(); unsigned char* ws = kp->ws;
            p4_norm_res((const float*)(ws + WS_BUF1), L == 0 ? kp->x : (const float*)kp->out, kp->out, (bf16_t*)(ws + WS_H), kp->norm_post + L * DM, L + 1 < DEPTH ? kp->norm_pre + (L + 1) * DM : nullptr, bx, G);
        }
        if (L + 1 < DEPTH) grid.sync();
}

__global__ void __launch_bounds__(NTHREADS, 2) trunk_fwd(Params Pin) {
    extern __shared__ __attribute__((aligned(16))) unsigned char lds_raw[];
    LAS unsigned char* lds = (LAS unsigned char*)lds_raw;
    cg::grid_group grid = cg::this_grid();
    const int G = gridDim.x, bx = blockIdx.x;

    p0_prologue(lds, bx, G);
    grid.sync();
    run_layer<0>(lds, grid, bx, G);
    run_layer<1>(lds, grid, bx, G);
    run_layer<2>(lds, grid, bx, G);
    run_layer<3>(lds, grid, bx, G);
}

extern "C" void kernel_launch(void* const* d_in, const int* in_sizes, int n_in, void* d_out, int out_size, void* d_ws, size_t ws_size, hipStream_t stream) {
    static int grid_blocks = 0;
    if (grid_blocks == 0) {
        if (n_in != 13 || ws_size < WS_END) { fprintf(stderr, "kernel_launch: unexpected n_in %d / ws_size %zu (need %zu)\n", n_in, ws_size, (size_t)WS_END); grid_blocks = -1; return; }
        int dev = 0, cus = 0, per_cu = 0;
        hipGetDevice(&dev); hipDeviceGetAttribute(&cus, hipDeviceAttributeMultiprocessorCount, dev);
        hipFuncSetAttribute((const void*)trunk_fwd, hipFuncAttributeMaxDynamicSharedMemorySize, LDS_BYTES);
        hipOccupancyMaxActiveBlocksPerMultiprocessor(&per_cu, (const void*)trunk_fwd, NTHREADS, LDS_BYTES);
        if (per_cu < 1) { fprintf(stderr, "kernel_launch: occupancy query says %d blocks per CU\n", per_cu); per_cu = 1; }
        (void)hipGetLastError();
        grid_blocks = cus * per_cu;
    }
    if (grid_blocks < 0) return;
    Params p{};
    p.x = (const float*)d_in[0]; p.norm_pre = (const float*)d_in[1]; p.norm_post = (const float*)d_in[2];
    p.a_w_in = (const float*)d_in[3]; p.a_ln_g = (const float*)d_in[4]; p.a_ln_b = (const float*)d_in[5]; p.a_w_s = (const float*)d_in[6]; p.a_b_s = (const float*)d_in[7]; p.a_w_out = (const float*)d_in[8];
    p.b_w_in = (const float*)d_in[9]; p.b_w_grp = (const float*)d_in[10]; p.b_scale = (const float*)d_in[11]; p.b_w_out = (const float*)d_in[12];
    p.out = (float*)d_out; p.ws = (unsigned char*)d_ws;
    void* args[] = {&p};
    hipError_t e = hipLaunchCooperativeKernel((const void*)trunk_fwd, dim3(grid_blocks), dim3(NTHREADS), args, LDS_BYTES, stream);
    if (e != hipSuccess) fprintf(stderr, "cooperative launch failed: %s (grid %d)\n", hipGetErrorString(e), grid_blocks);
}
```

```cpp
#include <hip/hip_runtime.h>
#include <hip/hip_cooperative_groups.h>
#include <cstdio>
#include <cstdint>
namespace cg = cooperative_groups;

#define LAS __attribute__((address_space(3)))
typedef unsigned short bf16_t;
typedef short bf16x8 __attribute__((ext_vector_type(8)));
typedef float f32x4 __attribute__((ext_vector_type(4)));
typedef float f32x2 __attribute__((ext_vector_type(2)));
typedef unsigned u32x4 __attribute__((ext_vector_type(4)));
typedef unsigned u32x2 __attribute__((ext_vector_type(2)));

constexpr int DM = 1024, BATCH = 8, SEQ = 4096, DEPTH = 4, EB = 2048, MTOK = BATCH * SEQ;
constexpr float EPS = 1e-6f;
constexpr int NWAVES = 8, NTHREADS = 512;

constexpr size_t MiB = 1u << 20;
constexpr size_t WS_WA_IN = 0;
constexpr size_t WS_WA_OUT = 24 * MiB;
constexpr size_t WS_WB_IN = 32 * MiB;
constexpr size_t WS_WB_GRP = 48 * MiB;
constexpr size_t WS_WB_OUT = 52 * MiB;
constexpr size_t WS_WS = 60 * MiB;
constexpr size_t WS_H = 61 * MiB;
constexpr size_t WS_BUF0 = 125 * MiB;
constexpr size_t WS_BUF1 = 253 * MiB;
constexpr size_t WS_BUF2 = 381 * MiB;
constexpr size_t WS_CTL = 509 * MiB;
constexpr size_t WS_END = 510 * MiB;

namespace pg8 {
constexpr int BM = 256, BK = 64, HALF = 128, HTB = HALF * BK * 2, STAGE_BYTES = 8 * HTB, NXCD = 8, WGM = 8;
__host__ __device__ __forceinline__ int lds_byte(int r, int c) { const int st = (r >> 4) * 2 + (c >> 5), rr = r & 15, cc = c & 31, ob = rr * 64 + cc * 2; return st * 1024 + (ob ^ (((ob >> 9) & 1) << 5)); }
__host__ __device__ __forceinline__ void stage_rc(int b, int& R, int& C) { const int st = b / 1024, sb = b % 1024, swz = sb ^ (((sb >> 9) & 1) << 5); R = (st >> 1) * 16 + swz / 64; C = (st & 1) * 32 + (swz % 64) / 2; }
__host__ __device__ __forceinline__ int perm32(int rho) { const int n = rho >> 4, i = rho & 15; return 8 * (i >> 2) + 4 * n + (i & 3); }

struct Unit { int pm, pn; };
struct Gemm { const bf16_t* A; const bf16_t* Bt; int M, N, K, lda, a_gdiv, a_goff; };

struct StaticOrder {
    int nM, nN, nwg, G, c;
    __host__ __device__ void init(int M, int N, int G_, int c_) { nM = M / BM; nN = N / BM; nwg = nM * nN; G = G_; c = c_; }
    __host__ __device__ bool next(int i, Unit& u) const {
        const long L = (long)i * G + c; if (L >= nwg) return false;
        int wgid = (int)L; { const int q = nwg / NXCD, r = nwg % NXCD, xcd = wgid % NXCD, off = wgid / NXCD; wgid = (xcd < r ? xcd * (q + 1) : r * (q + 1) + (xcd - r) * q) + off; }
        const int nig = WGM * nN, gid = wgid / nig, fm = gid * WGM, gsz = (nM - fm) < WGM ? (nM - fm) : WGM;
        u.pm = fm + ((wgid % nig) % gsz); u.pn = (wgid % nig) / gsz; return true;
    }
};

__device__ __forceinline__ unsigned cvt_pk_bf16(float lo, float hi) { unsigned r; asm volatile("v_cvt_pk_bf16_f32 %0, %1, %2" : "=v"(r) : "v"(lo), "v"(hi)); return r; }
__device__ __forceinline__ float bf_lo(unsigned w) { return __uint_as_float(w << 16); }
__device__ __forceinline__ float bf_hi(unsigned w) { return __uint_as_float(w & 0xffff0000u); }
__device__ __forceinline__ float gelu_f(float x) { const float a = x * (1.0f + 0.044715f * x * x) * (-2.0f * 0.7978845608028654f * 1.4426950408889634f); return x * __builtin_amdgcn_rcpf(1.0f + __builtin_amdgcn_exp2f(a)); }
__device__ __forceinline__ float silu_f(float x) { return x * __builtin_amdgcn_rcpf(1.0f + __builtin_amdgcn_exp2f(x * -1.4426950408889634f)); }
__device__ __forceinline__ f32x4 gelu4(f32x4 v) { return (f32x4){gelu_f(v[0]), gelu_f(v[1]), gelu_f(v[2]), gelu_f(v[3])}; }
__device__ __forceinline__ f32x4 silu4(f32x4 v) { return (f32x4){silu_f(v[0]), silu_f(v[1]), silu_f(v[2]), silu_f(v[3])}; }
__device__ __forceinline__ u32x4 pack8(f32x4 a, f32x4 b) { u32x4 w; w.x = cvt_pk_bf16(a[0], a[1]); w.y = cvt_pk_bf16(a[2], a[3]); w.z = cvt_pk_bf16(b[0], b[1]); w.w = cvt_pk_bf16(b[2], b[3]); return w; }

struct EpiA1 {
    static constexpr bool PERM = true;
    bf16_t* V; bf16_t* UZ; f32x2* stats;
    __device__ __forceinline__ void operator()(const f32x4 (&acc)[2][2][4][2], const Unit& u, int wr, int wc, int fr, int fq) const {
        const int row0 = u.pm * BM + wr * 64 + fr;
        if (u.pn < 8) {
            const int col0 = u.pn * BM + wc * 32 + 8 * fq;
#pragma unroll
            for (int ai = 0; ai < 2; ++ai)
#pragma unroll
                for (int m = 0; m < 4; ++m) {
                    const int row = row0 + ai * HALF + m * 16; float s1 = 0.f, s2 = 0.f;
#pragma unroll
                    for (int bj = 0; bj < 2; ++bj) {
                        const f32x4 v0 = gelu4(acc[ai][bj][m][0]), v1 = gelu4(acc[ai][bj][m][1]);
                        s1 += ((v0[0] + v0[1]) + (v0[2] + v0[3])) + ((v1[0] + v1[1]) + (v1[2] + v1[3]));
                        s2 += ((v0[0] * v0[0] + v0[1] * v0[1]) + (v0[2] * v0[2] + v0[3] * v0[3])) + ((v1[0] * v1[0] + v1[1] * v1[1]) + (v1[2] * v1[2] + v1[3] * v1[3]));
                        *(u32x4*)(V + (size_t)row * EB + col0 + bj * HALF) = pack8(v0, v1);
                    }
                    s1 += __shfl_xor(s1, 16); s1 += __shfl_xor(s1, 32); s2 += __shfl_xor(s2, 16); s2 += __shfl_xor(s2, 32);
                    if (fq == 0) stats[((size_t)row * 8 + u.pn) * 4 + wc] = (f32x2){s1, s2};
                }
        } else {
            const int col0 = (u.pn - 8) * HALF + wc * 32 + 8 * fq;
#pragma unroll
            for (int ai = 0; ai < 2; ++ai)
#pragma unroll
                for (int m = 0; m < 4; ++m) {
                    const int row = row0 + ai * HALF + m * 16;
                    const f32x4 v0 = gelu4(acc[ai][0][m][0]) * silu4(acc[ai][1][m][0]), v1 = gelu4(acc[ai][0][m][1]) * silu4(acc[ai][1][m][1]);
                    *(u32x4*)(UZ + (size_t)row * EB + col0) = pack8(v0, v1);
                }
        }
    }
};
struct EpiB1 {
    static constexpr bool PERM = true;
    bf16_t* XB; bf16_t* SZ;
    __device__ __forceinline__ void operator()(const f32x4 (&acc)[2][2][4][2], const Unit& u, int wr, int wc, int fr, int fq) const {
        const int row0 = u.pm * BM + wr * 64 + fr; const bool isz = u.pn >= 8;
        bf16_t* O = isz ? SZ : XB; const int col0 = (u.pn & 7) * BM + wc * 32 + 8 * fq;
#pragma unroll
        for (int ai = 0; ai < 2; ++ai)
#pragma unroll
            for (int m = 0; m < 4; ++m) {
                const int row = row0 + ai * HALF + m * 16;
#pragma unroll
                for (int bj = 0; bj < 2; ++bj) {
                    f32x4 v0 = acc[ai][bj][m][0], v1 = acc[ai][bj][m][1];
                    if (isz) { v0 = silu4(v0); v1 = silu4(v1); }
                    *(u32x4*)(O + (size_t)row * EB + col0 + bj * HALF) = pack8(v0, v1);
                }
            }
    }
};
struct EpiB2 {
    static constexpr bool PERM = true;
    bf16_t* Y; const float* scale;
    __device__ __forceinline__ void operator()(const f32x4 (&acc)[2][2][4][2], const Unit& u, int wr, int wc, int fr, int fq) const {
        const int row0 = u.pm * BM + wr * 64 + fr; const int col0 = u.pn * BM + wc * 32 + 8 * fq;
        f32x4 sc[2][2];
#pragma unroll
        for (int bj = 0; bj < 2; ++bj) { sc[bj][0] = *(const f32x4*)(scale + col0 + bj * HALF); sc[bj][1] = *(const f32x4*)(scale + col0 + bj * HALF + 4); }
#pragma unroll
        for (int ai = 0; ai < 2; ++ai)
#pragma unroll
            for (int m = 0; m < 4; ++m) {
                const int row = row0 + ai * HALF + m * 16;
#pragma unroll
                for (int bj = 0; bj < 2; ++bj) {
                    u32x4* p = (u32x4*)(Y + (size_t)row * EB + col0 + bj * HALF); const u32x4 z = *p;
                    f32x4 v0 = acc[ai][bj][m][0] * sc[bj][0], v1 = acc[ai][bj][m][1] * sc[bj][1];
                    v0 = v0 * (f32x4){bf_lo(z.x), bf_hi(z.x), bf_lo(z.y), bf_hi(z.y)}; v1 = v1 * (f32x4){bf_lo(z.z), bf_hi(z.z), bf_lo(z.w), bf_hi(z.w)};
                    *p = pack8(v0, v1);
                }
            }
    }
};
struct EpiF32 {
    static constexpr bool PERM = false;
    float* C;
    __device__ __forceinline__ void operator()(const f32x4 (&acc)[2][2][4][2], const Unit& u, int wr, int wc, int fr, int fq) const {
        const int row0 = u.pm * BM + wr * 64 + fr, col0 = u.pn * BM + wc * 32 + 4 * fq;
#pragma unroll
        for (int ai = 0; ai < 2; ++ai)
#pragma unroll
            for (int m = 0; m < 4; ++m) { float* rowp = C + (size_t)(row0 + ai * HALF + m * 16) * DM + col0;
#pragma unroll
                for (int bj = 0; bj < 2; ++bj)
#pragma unroll
                    for (int n = 0; n < 2; ++n) *(f32x4*)(rowp + bj * HALF + n * 16) = acc[ai][bj][m][n]; }
    }
};

template <class Epi, bool ALIGN_EPI = true>
__device__ __forceinline__ void gemm_phase(LAS unsigned char* lds, const Gemm g, const StaticOrder& S, const Epi& E) {
    int tid = threadIdx.x; asm volatile("" : "+v"(tid));
    const int wid = __builtin_amdgcn_readfirstlane(tid >> 6), lane = tid & 63, wr = wid >> 2, wc = wid & 3, fr = lane & 15, fq = lane >> 4;
    const int K = g.K, nt = K / BK, lda = g.lda;
    unsigned voffA[2], voffB[2];
#pragma unroll
    for (int i = 0; i < 2; ++i) { int R, C; stage_rc(tid * 16 + i * 8192, R, C); const int Rb = Epi::PERM ? ((R & ~31) + perm32(R & 31)) : R;
        voffA[i] = (unsigned)(R * lda + C) * 2u; voffB[i] = (unsigned)(Rb * K + C) * 2u; }
    const size_t kstep = (size_t)(BK * 2);
    const size_t hstepA = (size_t)HALF * lda * 2, hstepB = (size_t)HALF * K * 2;
    const unsigned ldsw = (unsigned)wid * 1024u;
    const int aoff = lds_byte(wr * 64 + fr, fq * 8), boff = lds_byte(wc * 32 + fr, fq * 8);
#define PG8_APTR(u) ((const char*)g.A + ((size_t)(u).pm * BM * lda + (size_t)(g.a_gdiv ? ((u).pn / g.a_gdiv) * g.a_goff : 0)) * 2)
#define PG8_BPTR(u) ((const char*)g.Bt + (size_t)(u).pn * BM * K * 2)
#define PG8_SA(b, h) (((b) * 2 + (h)) * HTB)
#define PG8_SB(b, h) ((4 + (b) * 2 + (h)) * HTB)
#define PG8_STAGE(bufoff, gbase, voff) do { _Pragma("unroll") for (int _i = 0; _i < 2; ++_i) \
        __builtin_amdgcn_global_load_lds((const unsigned*)((const char*)(gbase) + (voff)[_i]), (LAS unsigned*)(lds + (bufoff) + ldsw + _i * 8192), 16, 0, 0); } while (0)
#define PG8_LDA(dst, b, h) do { _Pragma("unroll") for (int m = 0; m < 4; ++m) _Pragma("unroll") for (int k = 0; k < 2; ++k) dst[m][k] = *(const LAS bf16x8*)(lds + PG8_SA(b, h) + aoff + m * 2048 + k * 1024); } while (0)
#define PG8_LDB(dst, b, h) do { _Pragma("unroll") for (int n = 0; n < 2; ++n) _Pragma("unroll") for (int k = 0; k < 2; ++k) dst[n][k] = *(const LAS bf16x8*)(lds + PG8_SB(b, h) + boff + n * 2048 + k * 1024); } while (0)
#define PG8_MMA(ai, bj, At, Bt) do { __builtin_amdgcn_s_setprio(1); _Pragma("unroll") for (int m = 0; m < 4; ++m) _Pragma("unroll") for (int n = 0; n < 2; ++n) _Pragma("unroll") for (int k = 0; k < 2; ++k) \
        acc[ai][bj][m][n] = __builtin_amdgcn_mfma_f32_16x16x32_bf16(Bt[n][k], At[m][k], acc[ai][bj][m][n], 0, 0, 0); __builtin_amdgcn_s_setprio(0); } while (0)
#define PG8_WAIT_V(n) asm volatile("s_waitcnt vmcnt(" #n ")" ::: "memory")
#define PG8_WAIT_L(n) asm volatile("s_waitcnt lgkmcnt(" #n ")" ::: "memory")
#define PG8_BAR __builtin_amdgcn_s_barrier()
#define PG8_SCHED __builtin_amdgcn_sched_barrier(0)
    Unit cur, nxt; int ui = 0;
    if (!S.next(0, cur)) return;
    f32x4 acc[2][2][4][2];
#pragma unroll
    for (int a = 0; a < 2; ++a)
#pragma unroll
        for (int b = 0; b < 2; ++b)
#pragma unroll
            for (int m = 0; m < 4; ++m)
#pragma unroll
                for (int n = 0; n < 2; ++n) acc[a][b][m][n] = (f32x4){0.f, 0.f, 0.f, 0.f};
    bf16x8 At[4][2], B0[2][2], B1[2][2];
    const char* cA = PG8_APTR(cur); const char* cB = PG8_BPTR(cur);
    PG8_STAGE(PG8_SB(0, 0), cB, voffB); PG8_STAGE(PG8_SB(0, 1), cB + hstepB, voffB); PG8_STAGE(PG8_SA(0, 0), cA, voffA); PG8_STAGE(PG8_SA(0, 1), cA + hstepA, voffA);
    if (wr == 1) PG8_BAR;
    PG8_WAIT_V(2); PG8_BAR;
    PG8_STAGE(PG8_SB(1, 0), cB + kstep, voffB); PG8_STAGE(PG8_SA(1, 0), cA + kstep, voffA); PG8_STAGE(PG8_SB(1, 1), cB + hstepB + kstep, voffB);
    PG8_WAIT_V(6); PG8_BAR;
    for (;;) {
        const bool has_next = S.next(ui + 1, nxt);
        const char* nA = has_next ? PG8_APTR(nxt) : cA; const char* nB = has_next ? PG8_BPTR(nxt) : cB;
        for (int t = 0; t < nt; t += 2) {
            const bool last = (t == nt - 2);
            const char* a1 = cA + (size_t)(t + 1) * kstep;
            const char* a2 = last ? nA : cA + (size_t)(t + 2) * kstep; const char* b2 = last ? nB : cB + (size_t)(t + 2) * kstep;
            const char* a3 = a2 + kstep; const char* b3 = b2 + kstep;
            PG8_LDB(B0, 0, 0); PG8_LDB(B1, 0, 1); PG8_SCHED; PG8_LDA(At, 0, 0); PG8_STAGE(PG8_SA(1, 1), a1 + hstepA, voffA);
            PG8_WAIT_V(8); PG8_WAIT_L(0); PG8_BAR; PG8_MMA(0, 0, At, B0); PG8_MMA(0, 1, At, B1); PG8_BAR; PG8_SCHED;
            PG8_LDA(At, 0, 1); PG8_STAGE(PG8_SB(0, 0), b2, voffB); PG8_STAGE(PG8_SB(0, 1), b2 + hstepB, voffB); PG8_STAGE(PG8_SA(0, 0), a2, voffA);
            PG8_WAIT_V(8); PG8_WAIT_L(0); PG8_BAR; PG8_MMA(1, 0, At, B0); PG8_MMA(1, 1, At, B1); PG8_BAR; PG8_SCHED;
            PG8_LDB(B0, 1, 0); PG8_LDB(B1, 1, 1); PG8_SCHED; PG8_LDA(At, 1, 0); PG8_STAGE(PG8_SA(0, 1), a2 + hstepA, voffA);
            PG8_WAIT_V(8); PG8_WAIT_L(0); PG8_BAR; PG8_MMA(0, 0, At, B0); PG8_MMA(0, 1, At, B1); PG8_BAR; PG8_SCHED;
            PG8_LDA(At, 1, 1); PG8_STAGE(PG8_SB(1, 0), b3, voffB); PG8_STAGE(PG8_SB(1, 1), b3 + hstepB, voffB); PG8_STAGE(PG8_SA(1, 0), a3, voffA);
            PG8_WAIT_V(8); PG8_WAIT_L(0); PG8_BAR; PG8_MMA(1, 0, At, B0); PG8_MMA(1, 1, At, B1); PG8_BAR; PG8_SCHED;
        }
        if constexpr (ALIGN_EPI) { if (wr == 0) PG8_BAR; }
        E(acc, cur, wr, wc, fr, fq);
        if (!has_next) break;
#pragma unroll
        for (int a = 0; a < 2; ++a)
#pragma unroll
            for (int b = 0; b < 2; ++b)
#pragma unroll
                for (int m = 0; m < 4; ++m)
#pragma unroll
                    for (int n = 0; n < 2; ++n) acc[a][b][m][n] = (f32x4){0.f, 0.f, 0.f, 0.f};
        cur = nxt; cA = nA; cB = nB; ++ui;
        if constexpr (ALIGN_EPI) { if (wr == 1) PG8_BAR; }
    }
    PG8_WAIT_V(0);
    if constexpr (!ALIGN_EPI) { if (wr == 0) PG8_BAR; }
    PG8_BAR;
#undef PG8_APTR
#undef PG8_BPTR
#undef PG8_SA
#undef PG8_SB
#undef PG8_STAGE
#undef PG8_LDA
#undef PG8_LDB
#undef PG8_MMA
#undef PG8_WAIT_V
#undef PG8_WAIT_L
#undef PG8_BAR
#undef PG8_SCHED
}
}

__device__ __forceinline__ unsigned f2bf(float f) { unsigned u = __float_as_uint(f); return (u + 0x7fffu + ((u >> 16) & 1u)) >> 16; }
__device__ __forceinline__ float wave_sum(float v) {
#pragma unroll
    for (int o = 1; o < 64; o <<= 1) v += __shfl_xor(v, o);
    return v;
}

struct Params {
    const float* x; const float* norm_pre; const float* norm_post;
    const float* a_w_in; const float* a_ln_g; const float* a_ln_b; const float* a_w_s; const float* a_b_s; const float* a_w_out;
    const float* b_w_in; const float* b_w_grp; const float* b_scale; const float* b_w_out;
    float* out; unsigned char* ws;
};

typedef const __attribute__((address_space(4))) Params CParams;
__device__ __forceinline__ CParams* kparams() { CParams* kp = (CParams*)__builtin_amdgcn_kernarg_segment_ptr(); asm volatile("" : "+s"(kp)); return kp; }

__device__ __forceinline__ void transpose_item(const float* W, int ldw, int K, bf16_t* WT, int k0, int nsrc, int ndst, LAS float* scr, int lane) {
#pragma unroll 8
    for (int i = 0; i < 32; ++i) { const int kk = 2 * i + (lane >> 5); scr[kk * 33 + (lane & 31)] = W[(size_t)(k0 + kk) * ldw + nsrc + (lane & 31)]; }
    asm volatile("s_waitcnt lgkmcnt(0)" ::: "memory");
    const int c = lane & 7;
#pragma unroll
    for (int j = 0; j < 4; ++j) { const int n = (lane >> 3) + 8 * j; const LAS float* s = scr + (8 * c) * 33 + n;
        u32x4 o; o.x = pg8::cvt_pk_bf16(s[0 * 33], s[1 * 33]); o.y = pg8::cvt_pk_bf16(s[2 * 33], s[3 * 33]); o.z = pg8::cvt_pk_bf16(s[4 * 33], s[5 * 33]); o.w = pg8::cvt_pk_bf16(s[6 * 33], s[7 * 33]);
        *(u32x4*)(WT + (size_t)(ndst + n) * K + k0 + 8 * c) = o; }
    asm volatile("s_waitcnt lgkmcnt(0)" ::: "memory");
}

__device__ __forceinline__ int a_in_src_col(int n) { const int pn = n >> 8, r = n & 255; if (pn < 8) return 2048 + n; const int t = pn - 8; return r < 128 ? 128 * t + r : 4096 + 128 * t + (r - 128); }

__device__ __forceinline__ void p0_prologue(LAS unsigned char* lds, int bx, int G) {
    CParams* kp = kparams();
    struct { const float *x, *norm_pre, *a_w_in, *a_w_s, *a_w_out, *b_w_in, *b_w_grp, *b_w_out; unsigned char* ws; } P = {kp->x, kp->norm_pre, kp->a_w_in, kp->a_w_s, kp->a_w_out, kp->b_w_in, kp->b_w_grp, kp->b_w_out, kp->ws};
    int tid = threadIdx.x; asm volatile("" : "+v"(tid));
    const int lane = tid & 63, wave = __builtin_amdgcn_readfirstlane(tid >> 6), gw = bx * NWAVES + wave, NGW = G * NWAVES;
    LAS float* scr = (LAS float*)(lds + wave * 16384);
    unsigned char* ws = P.ws;
    constexpr int I_AIN = 16 * 192, I_AOUT = 32 * 32, I_BIN = 16 * 128, I_BGRP = 8 * 16, I_BOUT = 32 * 32;
    constexpr int NITEMS = 2 * I_AIN + 2 * I_AOUT + 2 * I_BIN + 8 * I_BGRP + 2 * I_BOUT;
    for (int it = gw; it < NITEMS; it += NGW) {
        int r = it;
        if (r < 2 * I_AIN) { const int j = r / I_AIN; r -= j * I_AIN; const int kb = r / 192, nb = r % 192;
            transpose_item(P.a_w_in + (size_t)j * 1024 * 6144, 6144, 1024, (bf16_t*)(ws + WS_WA_IN) + (size_t)j * 6144 * 1024, 64 * kb, a_in_src_col(32 * nb), 32 * nb, scr, lane); continue; }
        r -= 2 * I_AIN;
        if (r < 2 * I_AOUT) { const int j = r / I_AOUT; r -= j * I_AOUT; const int kb = r / 32, nb = r % 32;
            transpose_item(P.a_w_out + (size_t)j * 2048 * 1024, 1024, 2048, (bf16_t*)(ws + WS_WA_OUT) + (size_t)j * 1024 * 2048, 64 * kb, 32 * nb, 32 * nb, scr, lane); continue; }
        r -= 2 * I_AOUT;
        if (r < 2 * I_BIN) { const int j = r / I_BIN; r -= j * I_BIN; const int kb = r / 128, nb = r % 128;
            transpose_item(P.b_w_in + (size_t)j * 1024 * 4096, 4096, 1024, (bf16_t*)(ws + WS_WB_IN) + (size_t)j * 4096 * 1024, 64 * kb, 32 * nb, 32 * nb, scr, lane); continue; }
        r -= 2 * I_BIN;
        if (r < 8 * I_BGRP) { const int jg = r / I_BGRP; r -= jg * I_BGRP; const int kb = r / 16, nb = r % 16;
            transpose_item(P.b_w_grp + (size_t)jg * 512 * 512, 512, 512, (bf16_t*)(ws + WS_WB_GRP) + (size_t)jg * 512 * 512, 64 * kb, 32 * nb, 32 * nb, scr, lane); continue; }
        r -= 8 * I_BGRP;
        { const int j = r / I_BOUT; r -= j * I_BOUT; const int kb = r / 32, nb = r % 32;
            transpose_item(P.b_w_out + (size_t)j * 2048 * 1024, 1024, 2048, (bf16_t*)(ws + WS_WB_OUT) + (size_t)j * 1024 * 2048, 64 * kb, 32 * nb, 32 * nb, scr, lane); }
    }
    { bf16_t* wsb = (bf16_t*)(ws + WS_WS); const int gt = gw * 64 + lane, NT = NGW * 64;
      for (int i = gt; i < 2 * 8 * 128 * 128 / 4; i += NT) { const f32x4 v = *(const f32x4*)(P.a_w_s + (size_t)i * 4); const int q = (i * 4) & 127, p = ((i * 4) >> 7) & 127;
          const bool z = (p < 64) && (q >= 64); u32x2 o; o.x = z ? 0u : pg8::cvt_pk_bf16(v[0], v[1]); o.y = z ? 0u : pg8::cvt_pk_bf16(v[2], v[3]); *(u32x2*)(wsb + (size_t)i * 4) = o; } }
    { bf16_t* H = (bf16_t*)(ws + WS_H);
      f32x4 gp[4];
#pragma unroll
      for (int j = 0; j < 4; ++j) gp[j] = *((const f32x4*)P.norm_pre + lane + 64 * j);
      for (int m = gw; m < MTOK; m += NGW) {
          const f32x4* xr = (const f32x4*)(P.x + (size_t)m * DM) + lane; f32x4 v[4]; float s = 0.f;
#pragma unroll
          for (int j = 0; j < 4; ++j) { v[j] = xr[64 * j]; s += (v[j][0] * v[j][0] + v[j][1] * v[j][1]) + (v[j][2] * v[j][2] + v[j][3] * v[j][3]); }
          const float rstd = 1.0f / sqrtf(wave_sum(s) * (1.0f / DM) + EPS);
          u32x2* o = (u32x2*)(H + (size_t)m * DM) + lane;
#pragma unroll
          for (int j = 0; j < 4; ++j) { const f32x4 y = v[j] * rstd * gp[j]; u32x2 w; w.x = pg8::cvt_pk_bf16(y[0], y[1]); w.y = pg8::cvt_pk_bf16(y[2], y[3]); o[64 * j] = w; }
      } }
}

__device__ __forceinline__ void p4_norm_res(const float* O, const float* xin, float* xout, bf16_t* H, const float* g_post, const float* g_pre_next, int bx, int G) {
    int tid = threadIdx.x; asm volatile("" : "+v"(tid));
    const int lane = tid & 63, wave = __builtin_amdgcn_readfirstlane(tid >> 6), gw = bx * NWAVES + wave, NGW = G * NWAVES;
    f32x4 gq[4], gp[4];
#pragma unroll
    for (int j = 0; j < 4; ++j) { gq[j] = *((const f32x4*)g_post + lane + 64 * j); gp[j] = g_pre_next ? *((const f32x4*)g_pre_next + lane + 64 * j) : (f32x4){0.f, 0.f, 0.f, 0.f}; }
    for (int m = gw; m < MTOK; m += NGW) {
        const f32x4* orow = (const f32x4*)(O + (size_t)m * DM) + lane; const f32x4* xr = (const f32x4*)(xin + (size_t)m * DM) + lane;
        f32x4 o[4], xv[4]; float s = 0.f;
#pragma unroll
        for (int j = 0; j < 4; ++j) { o[j] = orow[64 * j]; xv[j] = xr[64 * j]; s += (o[j][0] * o[j][0] + o[j][1] * o[j][1]) + (o[j][2] * o[j][2] + o[j][3] * o[j][3]); }
        const float r1 = 1.0f / sqrtf(wave_sum(s) * (1.0f / DM) + EPS); float s2 = 0.f;
        f32x4* xo = (f32x4*)(xout + (size_t)m * DM) + lane;
#pragma unroll
        for (int j = 0; j < 4; ++j) { xv[j] = xv[j] + o[j] * r1 * gq[j]; xo[64 * j] = xv[j]; s2 += (xv[j][0] * xv[j][0] + xv[j][1] * xv[j][1]) + (xv[j][2] * xv[j][2] + xv[j][3] * xv[j][3]); }
        if (g_pre_next) {
            const float r2 = 1.0f / sqrtf(wave_sum(s2) * (1.0f / DM) + EPS);
            u32x2* ho = (u32x2*)(H + (size_t)m * DM) + lane;
#pragma unroll
            for (int j = 0; j < 4; ++j) { const f32x4 y = xv[j] * r2 * gp[j]; u32x2 w; w.x = pg8::cvt_pk_bf16(y[0], y[1]); w.y = pg8::cvt_pk_bf16(y[2], y[3]); ho[64 * j] = w; }
        }
    }
}

__device__ __forceinline__ void mix_phase(LAS unsigned char* lds, const bf16_t* V, bf16_t* UZ, const f32x2* stats, const bf16_t* WSb, const float* lng, const float* lnb, const float* bs, int G, int c) {
    constexpr int RS = 272;
    LAS unsigned char* VT = lds; LAS unsigned char* WL = lds + 256 * RS; LAS float* MU = (LAS float*)(lds + 384 * RS); LAS float* RD = MU + 128;
    int tid = threadIdx.x; asm volatile("" : "+v"(tid));
    const int wid = tid >> 6, lane = tid & 63, fr = lane & 15, fq = lane >> 4;
    for (int tile = c; tile < (MTOK / 128) * 8; tile += G) {
        const int nb = tile >> 3, g = tile & 7;
        if (tid < 128) {
            const f32x4* sp = (const f32x4*)(stats + (size_t)(nb * 128 + tid) * 32); float s1 = 0.f, s2 = 0.f;
#pragma unroll
            for (int i = 0; i < 16; ++i) { const f32x4 v = sp[i]; s1 += v[0] + v[2]; s2 += v[1] + v[3]; }
            const float mean = s1 * (1.0f / EB); const float var = s2 * (1.0f / EB) - mean * mean;
            MU[tid] = mean; RD[tid] = 1.0f / sqrtf(fmaxf(var, 0.f) + EPS);
        }
        for (int i = tid; i < 2048; i += NTHREADS) { const int p = i >> 4, ch = i & 15; *(LAS u32x4*)(WL + p * RS + ch * 16) = *(const u32x4*)(WSb + ((size_t)g * 128 + p) * 128 + ch * 8); }
        __syncthreads();
        {
            const int q = 16 * wid + (lane >> 2); const float mu = MU[q], rd = RD[q];
            const bf16_t* vrow = V + (size_t)(nb * 128 + q) * EB + g * 256;
#pragma unroll 2
            for (int i = 0; i < 8; ++i) {
                const int cc = (lane & 3) + 4 * i; const u32x4 raw = *(const u32x4*)(vrow + cc * 8);
                const f32x4 ga = *(const f32x4*)(lng + g * 256 + cc * 8), gb = *(const f32x4*)(lng + g * 256 + cc * 8 + 4), ba = *(const f32x4*)(lnb + g * 256 + cc * 8), bb = *(const f32x4*)(lnb + g * 256 + cc * 8 + 4);
                float val[8] = {pg8::bf_lo(raw.x), pg8::bf_hi(raw.x), pg8::bf_lo(raw.y), pg8::bf_hi(raw.y), pg8::bf_lo(raw.z), pg8::bf_hi(raw.z), pg8::bf_lo(raw.w), pg8::bf_hi(raw.w)};
#pragma unroll
                for (int e = 0; e < 8; ++e) { const float gg = e < 4 ? ga[e & 3] : gb[e & 3], bbv = e < 4 ? ba[e & 3] : bb[e & 3];
                    const float y = (val[e] - mu) * rd * gg + bbv; const int ch = cc * 8 + e; const int rho = (ch & ~31) + 16 * ((ch >> 2) & 1) + 4 * ((ch >> 3) & 3) + (ch & 3);
                    *(LAS unsigned short*)(VT + rho * RS + q * 2) = (unsigned short)f2bf(y); }
            }
        }
        __syncthreads();
        f32x4 acc[8][2];
#pragma unroll
        for (int m = 0; m < 8; ++m) { acc[m][0] = (f32x4){0.f, 0.f, 0.f, 0.f}; acc[m][1] = (f32x4){0.f, 0.f, 0.f, 0.f}; }
#pragma unroll
        for (int kk = 0; kk < 4; ++kk) {
            bf16x8 bfr[2];
#pragma unroll
            for (int n = 0; n < 2; ++n) bfr[n] = *(const LAS bf16x8*)(VT + (32 * wid + 16 * n + fr) * RS + (32 * kk + 8 * fq) * 2);
#pragma unroll
            for (int m = 0; m < 8; ++m) {
                if (m < 4 && kk >= 2) continue;
                const bf16x8 afr = *(const LAS bf16x8*)(WL + (16 * m + fr) * RS + (32 * kk + 8 * fq) * 2);
#pragma unroll
                for (int n = 0; n < 2; ++n) acc[m][n] = __builtin_amdgcn_mfma_f32_16x16x32_bf16(bfr[n], afr, acc[m][n], 0, 0, 0);
            }
        }
#pragma unroll
        for (int m = 0; m < 8; ++m) {
            const int p = 16 * m + fr; const float bias = bs[g * 128 + p];
            u32x4* ptr = (u32x4*)(UZ + (size_t)(nb * 128 + p) * EB + g * 256 + 32 * wid + 8 * fq); const u32x4 z = *ptr;
            const f32x4 v0 = (acc[m][0] + bias) * (f32x4){pg8::bf_lo(z.x), pg8::bf_hi(z.x), pg8::bf_lo(z.y), pg8::bf_hi(z.y)};
            const f32x4 v1 = (acc[m][1] + bias) * (f32x4){pg8::bf_lo(z.z), pg8::bf_hi(z.z), pg8::bf_lo(z.w), pg8::bf_hi(z.w)};
            *ptr = pg8::pack8(v0, v1);
        }
        __syncthreads();
    }
}

__device__ __forceinline__ void pool_phase(const bf16_t* XB, bf16_t* XP, int bx, int G) {
    constexpr int RUN = 32;
    int tid = threadIdx.x; asm volatile("" : "+v"(tid));
    const int gtid = bx * NTHREADS + tid, nthreads = G * NTHREADS;
    for (int item = gtid; item < (MTOK / RUN) * 256; item += nthreads) {
        const int r = item >> 8, cc = item & 255, gi = cc >> 6, w = 2 << gi;
        const int t0 = r * RUN, tt0 = t0 & (SEQ - 1);
        const bf16_t* xp = XB + (size_t)t0 * EB + cc * 8; bf16_t* op = XP + (size_t)t0 * EB + cc * 8;
        float sum[8];
#pragma unroll
        for (int e = 0; e < 8; ++e) sum[e] = 0.f;
        if (tt0 != 0) for (int s = 1; s < w; ++s) { const u32x4 v = *(const u32x4*)(xp - (size_t)s * EB);
            sum[0] += pg8::bf_lo(v.x); sum[1] += pg8::bf_hi(v.x); sum[2] += pg8::bf_lo(v.y); sum[3] += pg8::bf_hi(v.y); sum[4] += pg8::bf_lo(v.z); sum[5] += pg8::bf_hi(v.z); sum[6] += pg8::bf_lo(v.w); sum[7] += pg8::bf_hi(v.w); }
        for (int i = 0; i < RUN; ++i) {
            const int tt = tt0 + i; const u32x4 v = *(const u32x4*)(xp + (size_t)i * EB);
            const float xv[8] = {pg8::bf_lo(v.x), pg8::bf_hi(v.x), pg8::bf_lo(v.y), pg8::bf_hi(v.y), pg8::bf_lo(v.z), pg8::bf_hi(v.z), pg8::bf_lo(v.w), pg8::bf_hi(v.w)};
            const float inv = 1.0f / (float)(tt + 1 < w ? tt + 1 : w); float o[8];
#pragma unroll
            for (int e = 0; e < 8; ++e) { sum[e] += xv[e]; o[e] = sum[e] * inv - xv[e]; }
            u32x4 ov; ov.x = pg8::cvt_pk_bf16(o[0], o[1]); ov.y = pg8::cvt_pk_bf16(o[2], o[3]); ov.z = pg8::cvt_pk_bf16(o[4], o[5]); ov.w = pg8::cvt_pk_bf16(o[6], o[7]);
            *(u32x4*)(op + (size_t)i * EB) = ov;
            if (tt + 1 >= w) { const u32x4 d = *(const u32x4*)(xp + (size_t)(i - w + 1) * EB);
                sum[0] -= pg8::bf_lo(d.x); sum[1] -= pg8::bf_hi(d.x); sum[2] -= pg8::bf_lo(d.y); sum[3] -= pg8::bf_hi(d.y); sum[4] -= pg8::bf_lo(d.z); sum[5] -= pg8::bf_hi(d.z); sum[6] -= pg8::bf_lo(d.w); sum[7] -= pg8::bf_hi(d.w); }
        }
    }
}

#define XB_TMO      128
#define XB_XCNT(j)  (256  + 64 * (j))
#define XB_XSUB(j)  (1280 + 64 * (j))
#define XB_XGEN(j)  (2304 + 64 * (j))
#define XB_TOP      3328
#define XB_TOPGEN   3392
#define XCD_BAR_WORDS 3456
#define XB_SPIN_CAP (1u << 18)
__device__ __forceinline__ unsigned xb_ld(unsigned* p)              { return __hip_atomic_load(p, __ATOMIC_RELAXED, __HIP_MEMORY_SCOPE_AGENT); }
__device__ __forceinline__ unsigned xb_add(unsigned* p, unsigned v) { return __hip_atomic_fetch_add(p, v, __ATOMIC_RELAXED, __HIP_MEMORY_SCOPE_AGENT); }
__device__ __forceinline__ unsigned xb_xcc_id() { return (unsigned)__builtin_amdgcn_s_getreg((3 << 11) | 20) & 0xFu; }
#define XB_SPIN(cond, bar) do { unsigned _sp = 0; while (cond) { __builtin_amdgcn_s_sleep(1); \
    if ((++_sp & 255u) == 0u) { if (xb_ld(&(bar)[XB_TMO])) break; if (_sp > XB_SPIN_CAP) { atomicAdd(&(bar)[XB_TMO], 1u); break; } } } } while (0)
struct XcdBarrier { unsigned* bar; unsigned x; volatile LAS unsigned* st; };
__device__ __forceinline__ XcdBarrier xcd_barrier_post(unsigned* bar, volatile LAS unsigned* st) {
    XcdBarrier b; b.bar = bar; b.x = xb_xcc_id(); b.st = st;
    if (threadIdx.x == 0) (void)xb_add(&bar[XB_XCNT(b.x)], 1u);
    return b;
}
__device__ __forceinline__ void xcd_barrier_complete(unsigned* bar, unsigned x, unsigned& nloc, unsigned& nx) {
    const unsigned G = gridDim.x * gridDim.y * gridDim.z;
    unsigned sum, cnt, mine, sp = 0u;
    for (;;) {
        sum = 0u; cnt = 0u; mine = 0u;
#pragma unroll
        for (unsigned j = 0; j < 16; ++j) { const unsigned c = xb_ld(&bar[XB_XCNT(j)]); sum += c; cnt += (c > 0u) ? 1u : 0u; mine = (j == x) ? c : mine; }
        if (sum == G) break;
        __builtin_amdgcn_s_sleep(1);
        if ((++sp & 255u) == 0u) { if (xb_ld(&bar[XB_TMO])) break; if (sp > XB_SPIN_CAP) { atomicAdd(&bar[XB_TMO], 1u); break; } }
    }
    nloc = mine > 0u ? mine : 1u; nx = cnt > 0u ? cnt : 1u;
}
__device__ __forceinline__ void xcd_barrier(const XcdBarrier& b) {
    asm volatile("s_waitcnt vmcnt(0)" ::: "memory");
    __syncthreads();
    if (threadIdx.x == 0) {
        unsigned* bar = b.bar;
        __builtin_amdgcn_s_waitcnt(0);
        unsigned nloc = b.st[0], nx = b.st[1];
        if (nloc == 0u) { xcd_barrier_complete(bar, b.x, nloc, nx); b.st[0] = nloc; b.st[1] = nx; }
        const unsigned old = xb_add(&bar[XB_XSUB(b.x)], 1u);
        const unsigned gen = old / nloc;
        if (old + 1u == (gen + 1u) * nloc) {
            __builtin_amdgcn_fence(__ATOMIC_RELEASE, "agent");
            asm volatile("s_waitcnt vmcnt(0)" ::: "memory");
            const unsigned og = xb_add(&bar[XB_TOP], 1u);
            const unsigned tg = og / nx;
            if (og + 1u == (tg + 1u) * nx) xb_add(&bar[XB_TOPGEN], 1u);
            else XB_SPIN(xb_ld(&bar[XB_TOPGEN]) == tg, bar);
            __builtin_amdgcn_fence(__ATOMIC_ACQUIRE, "agent");
            xb_add(&bar[XB_XGEN(b.x)], 1u);
            asm volatile("s_waitcnt vmcnt(0)" ::: "memory");
        } else {
            XB_SPIN(xb_ld(&bar[XB_XGEN(b.x)]) == gen, bar);
            __builtin_amdgcn_fence(__ATOMIC_ACQUIRE, "agent");
            asm volatile("s_waitcnt vmcnt(0)" ::: "memory");
        }
    }
    __syncthreads();
}

constexpr int LDS_BYTES = 147456;
constexpr int LDS_BARST = LDS_BYTES - 64;


template <int L> __device__ __forceinline__ void run_layer(LAS unsigned char* lds, const XcdBarrier& xbar, const int bx, const int G) {
        const int j = L >> 1;
        if constexpr ((L & 1) == 0) {
            {
                CParams* kp = kparams(); unsigned char* ws = kp->ws;
                pg8::Gemm g{(const bf16_t*)(ws + WS_H), (const bf16_t*)(ws + WS_WA_IN) + (size_t)j * 6144 * 1024, MTOK, 6144, 1024, 1024, 0, 0};
                pg8::StaticOrder S; S.init(MTOK, 6144, G, bx);
                pg8::EpiA1 E{(bf16_t*)(ws + WS_BUF1), (bf16_t*)(ws + WS_BUF0), (f32x2*)(ws + WS_BUF2)};
                pg8::gemm_phase<pg8::EpiA1>(lds, g, S, E);
            }
            xcd_barrier(xbar);
            {
                CParams* kp = kparams(); unsigned char* ws = kp->ws;
                mix_phase(lds, (const bf16_t*)(ws + WS_BUF1), (bf16_t*)(ws + WS_BUF0), (const f32x2*)(ws + WS_BUF2), (const bf16_t*)(ws + WS_WS) + (size_t)j * 8 * 128 * 128, kp->a_ln_g + j * EB, kp->a_ln_b + j * EB, kp->a_b_s + j * 8 * 128, G, bx);
            }
            xcd_barrier(xbar);
            {
                CParams* kp = kparams(); unsigned char* ws = kp->ws;
                pg8::Gemm g{(const bf16_t*)(ws + WS_BUF0), (const bf16_t*)(ws + WS_WA_OUT) + (size_t)j * 1024 * 2048, MTOK, 1024, 2048, 2048, 0, 0};
                pg8::StaticOrder S; S.init(MTOK, 1024, G, bx);
                pg8::EpiF32 E{(float*)(ws + WS_BUF1)};
                pg8::gemm_phase<pg8::EpiF32>(lds, g, S, E);
            }
            xcd_barrier(xbar);
        } else {
            {
                CParams* kp = kparams(); unsigned char* ws = kp->ws;
                pg8::Gemm g{(const bf16_t*)(ws + WS_H), (const bf16_t*)(ws + WS_WB_IN) + (size_t)j * 4096 * 1024, MTOK, 4096, 1024, 1024, 0, 0};
                pg8::StaticOrder S; S.init(MTOK, 4096, G, bx);
                pg8::EpiB1 E{(bf16_t*)(ws + WS_BUF1), (bf16_t*)(ws + WS_BUF0)};
                pg8::gemm_phase<pg8::EpiB1>(lds, g, S, E);
            }
            xcd_barrier(xbar);
            { CParams* kp = kparams(); unsigned char* ws = kp->ws; pool_phase((const bf16_t*)(ws + WS_BUF1), (bf16_t*)(ws + WS_BUF2), bx, G); }
            xcd_barrier(xbar);
            {
                CParams* kp = kparams(); unsigned char* ws = kp->ws;
                pg8::Gemm g{(const bf16_t*)(ws + WS_BUF2), (const bf16_t*)(ws + WS_WB_GRP) + (size_t)j * 2048 * 512, MTOK, 2048, 512, 2048, 2, 512};
                pg8::StaticOrder S; S.init(MTOK, 2048, G, bx);
                pg8::EpiB2 E{(bf16_t*)(ws + WS_BUF0), kp->b_scale + j * EB};
                pg8::gemm_phase<pg8::EpiB2>(lds, g, S, E);
            }
            xcd_barrier(xbar);
            {
                CParams* kp = kparams(); unsigned char* ws = kp->ws;
                pg8::Gemm g{(const bf16_t*)(ws + WS_BUF0), (const bf16_t*)(ws + WS_WB_OUT) + (size_t)j * 1024 * 2048, MTOK, 1024, 2048, 2048, 0, 0};
                pg8::StaticOrder S; S.init(MTOK, 1024, G, bx);
                pg8::EpiF32 E{(float*)(ws + WS_BUF1)};
                pg8::gemm_phase<pg8::EpiF32>(lds, g, S, E);
            }
            xcd_barrier(xbar);
        }
        {
            CParams* kp = kparams(); unsigned char* ws = kp->ws;
            p4_norm_res((const float*)(ws + WS_BUF1), L == 0 ? kp->x : (const float*)kp->out, kp->out, (bf16_t*)(ws + WS_H), kp->norm_post + L * DM, L + 1 < DEPTH ? kp->norm_pre + (L + 1) * DM : nullptr, bx, G);
        }
        if (L + 1 < DEPTH) xcd_barrier(xbar);
}

__global__ void __launch_bounds__(NTHREADS, 2) trunk_fwd(Params Pin) {
    extern __shared__ __attribute__((aligned(16))) unsigned char lds_raw[];
    LAS unsigned char* lds = (LAS unsigned char*)lds_raw;
    cg::grid_group grid = cg::this_grid();
    const int G = gridDim.x, bx = blockIdx.x;
    unsigned* ctl;
    {
        CParams* kp = kparams(); ctl = (unsigned*)(kp->ws + WS_CTL);
        if (bx == 0) for (int i = threadIdx.x; i < 4096; i += NTHREADS) __hip_atomic_store(ctl + i, 0u, __ATOMIC_RELAXED, __HIP_MEMORY_SCOPE_AGENT);
        if (threadIdx.x < 2) ((volatile LAS unsigned*)(lds + LDS_BARST))[threadIdx.x] = 0u;
    }
    p0_prologue(lds, bx, G);
    grid.sync();
    const XcdBarrier xbar = xcd_barrier_post(ctl, (volatile LAS unsigned*)(lds + LDS_BARST));
    run_layer<0>(lds, xbar, bx, G);
    run_layer<1>(lds, xbar, bx, G);
    run_layer<2>(lds, xbar, bx, G);
    run_layer<3>(lds, xbar, bx, G);
}

extern "C" void kernel_launch(void* const* d_in, const int* in_sizes, int n_in, void* d_out, int out_size, void* d_ws, size_t ws_size, hipStream_t stream) {
    static int grid_blocks = 0;
    if (grid_blocks == 0) {
        if (n_in != 13 || ws_size < WS_END) { fprintf(stderr, "kernel_launch: unexpected n_in %d / ws_size %zu (need %zu)\n", n_in, ws_size, (size_t)WS_END); grid_blocks = -1; return; }
        int dev = 0, cus = 0, per_cu = 0;
        hipGetDevice(&dev); hipDeviceGetAttribute(&cus, hipDeviceAttributeMultiprocessorCount, dev);
        hipFuncSetAttribute((const void*)trunk_fwd, hipFuncAttributeMaxDynamicSharedMemorySize, LDS_BYTES);
        hipOccupancyMaxActiveBlocksPerMultiprocessor(&per_cu, (const void*)trunk_fwd, NTHREADS, LDS_BYTES);
        if (per_cu < 1) { fprintf(stderr, "kernel_launch: occupancy query says %d blocks per CU\n", per_cu); per_cu = 1; }
        (void)hipGetLastError();
        grid_blocks = cus * per_cu;
    }
    if (grid_blocks < 0) return;
    Params p{};
    p.x = (const float*)d_in[0]; p.norm_pre = (const float*)d_in[1]; p.norm_post = (const float*)d_in[2];
    p.a_w_in = (const float*)d_in[3]; p.a_ln_g = (const float*)d_in[4]; p.a_ln_b = (const float*)d_in[5]; p.a_w_s = (const float*)d_in[6]; p.a_b_s = (const float*)d_in[7]; p.a_w_out = (const float*)d_in[8];
    p.b_w_in = (const float*)d_in[9]; p.b_w_grp = (const float*)d_in[10]; p.b_scale = (const float*)d_in[11]; p.b_w_out = (const float*)d_in[12];
    p.out = (float*)d_out; p.ws = (unsigned char*)d_ws;
    void* args[] = {&p};
    hipError_t e = hipLaunchCooperativeKernel((const void*)trunk_fwd, dim3(grid_blocks), dim3(NTHREADS), args, LDS_BYTES, stream);
    if (e != hipSuccess) fprintf(stderr, "cooperative launch failed: %s (grid %d)\n", hipGetErrorString(e), grid_blocks);
}
```
